# Optimizing an MI355X kernel written in HIP

```python
import math
import jax, jax.numpy as jnp
from jax import lax
import numpy as np

D_MODEL = 1024
BATCH = 8
SEQ = 2048
DEPTH = 2

GRID_W = 64
CTX_LEN = 256
DIFF_HEADS = 4
DIFF_HEAD_DIM = 64
GQA_HEADS = 8
GQA_KV_HEADS = 2
GQA_HEAD_DIM = 64
ROPE_THETA = 10000.0
ROPE_PAIRS_PER_AXIS = GQA_HEAD_DIM // 4
FOURIER_GROUPS = 8
FOURIER_GROUP_DIM = D_MODEL // FOURIER_GROUPS
D_FF = -(-8 * D_MODEL // (3 * 256)) * 256
Q_BLOCK = 128
EPS = 1e-6
N_MOD = 6

A_Q_W = DIFF_HEADS * 2 * DIFF_HEAD_DIM
A_K_W = DIFF_HEADS * 2 * DIFF_HEAD_DIM
A_V_W = DIFF_HEADS * 2 * DIFF_HEAD_DIM
B_Q_W = GQA_HEADS * GQA_HEAD_DIM
B_K_W = GQA_KV_HEADS * GQA_HEAD_DIM
B_V_W = GQA_KV_HEADS * GQA_HEAD_DIM
OFF_AQ = 0
OFF_AK = OFF_AQ + A_Q_W
OFF_AV = OFF_AK + A_K_W
OFF_BQ = OFF_AV + A_V_W
OFF_BK = OFF_BQ + B_Q_W
OFF_BV = OFF_BK + B_K_W
IN_WIDTH = OFF_BV + B_V_W
MIX_WIDTH = DIFF_HEADS * 2 * DIFF_HEAD_DIM + GQA_HEADS * GQA_HEAD_DIM

kernel_name = "hybrid_diffattn_gqa_fnet_dit_block"


def rms_norm(x, g):
    xf = x.astype(jnp.float32)
    y = xf * lax.rsqrt(jnp.mean(xf * xf, axis=-1, keepdims=True) + EPS)
    return (y * g.astype(jnp.float32)).astype(x.dtype)


def modulate(h, shift, scale):
    return h * (1 + scale) + shift


def ada_params(cond, w, b):
    m = jax.nn.silu(cond) @ w + b
    return [t[..., None, :] for t in jnp.split(m, N_MOD, axis=-1)]


def rope_tables(n_tokens):
    rows_count = n_tokens // GRID_W
    row = jnp.repeat(jnp.arange(rows_count, dtype=jnp.int32), GRID_W)
    col = jnp.tile(jnp.arange(GRID_W, dtype=jnp.int32), rows_count)
    inv = ROPE_THETA ** (-jnp.arange(ROPE_PAIRS_PER_AXIS, dtype=jnp.float32) / ROPE_PAIRS_PER_AXIS)
    ang = jnp.stack([row.astype(jnp.float32)[:, None] * inv, col.astype(jnp.float32)[:, None] * inv], axis=1)
    return jnp.cos(ang), jnp.sin(ang)


def apply_rope(x, cos, sin):
    b, s, n, d = x.shape
    xr = x.astype(jnp.float32).reshape(b, s, n, 2, 2, ROPE_PAIRS_PER_AXIS)
    x1, x2 = xr[..., 0, :], xr[..., 1, :]
    cb, sb = cos[None, :, None], sin[None, :, None]
    out = jnp.stack([x1 * cb - x2 * sb, x2 * cb + x1 * sb], axis=-2)
    return out.reshape(b, s, n, d).astype(x.dtype)


def to_blocks(t):
    b, s = t.shape[:2]
    return jnp.moveaxis(t.reshape(b, s // Q_BLOCK, Q_BLOCK, *t.shape[2:]), 1, 0)


def from_blocks(t):
    nb, b, q = t.shape[:3]
    return jnp.moveaxis(t, 0, 1).reshape(b, nb * q, *t.shape[3:])


def diff_attention(q1, q2, k1, k2, v, lam):
    scale = DIFF_HEAD_DIM ** -0.5

    def block(qb):
        b1, b2 = qb
        s1 = jnp.einsum('bqhd,bkhd->bhqk', b1, k1, preferred_element_type=jnp.float32) * scale
        s2 = jnp.einsum('bqhd,bkhd->bhqk', b2, k2, preferred_element_type=jnp.float32) * scale
        w = jax.nn.softmax(s1, axis=-1) - lam * jax.nn.softmax(s2, axis=-1)
        return jnp.einsum('bhqk,bkhe->bqhe', w.astype(v.dtype), v)

    return from_blocks(lax.map(block, (to_blocks(q1), to_blocks(q2))))


def gqa_attention(q, k, v):
    b = q.shape[0]
    grp = GQA_HEADS // GQA_KV_HEADS
    scale = GQA_HEAD_DIM ** -0.5

    def block(qb):
        qg = qb.reshape(b, Q_BLOCK, GQA_KV_HEADS, grp, GQA_HEAD_DIM)
        s = jnp.einsum('bqhgd,bkhd->bhgqk', qg, k, preferred_element_type=jnp.float32) * scale
        p = jax.nn.softmax(s, axis=-1)
        o = jnp.einsum('bhgqk,bkhd->bqhgd', p.astype(v.dtype), v)
        return o.reshape(b, Q_BLOCK, GQA_HEADS, GQA_HEAD_DIM)

    return from_blocks(lax.map(block, to_blocks(q)))


def attention_mixer(x, ctx, cos, sin, mod, mod_ctx, p, layer_idx):
    b, s, _ = x.shape
    n_ctx = ctx.shape[1]
    shift, scale, gate = mod
    shift_c, scale_c = mod_ctx
    h = modulate(rms_norm(x, p['norm_mix']), shift, scale)
    hc = modulate(rms_norm(ctx, p['norm_mix']), shift_c, scale_c)
    w_in = p['w_in']
    proj = h @ w_in
    ctx_a = hc @ w_in[:, OFF_AK:OFF_BQ]
    ctx_b = hc @ w_in[:, OFF_BK:IN_WIDTH]

    q_a = apply_rope(proj[..., OFF_AQ:OFF_AK].reshape(b, s, 2 * DIFF_HEADS, DIFF_HEAD_DIM), cos, sin)
    q_a = q_a.reshape(b, s, DIFF_HEADS, 2, DIFF_HEAD_DIM)
    k_a = apply_rope(proj[..., OFF_AK:OFF_AV].reshape(b, s, 2 * DIFF_HEADS, DIFF_HEAD_DIM), cos, sin)
    k_a = k_a.reshape(b, s, DIFF_HEADS, 2, DIFF_HEAD_DIM)
    v_a = proj[..., OFF_AV:OFF_BQ].reshape(b, s, DIFF_HEADS, 2 * DIFF_HEAD_DIM)
    kc_a = ctx_a[..., :A_K_W].reshape(b, n_ctx, DIFF_HEADS, 2, DIFF_HEAD_DIM)
    vc_a = ctx_a[..., A_K_W:].reshape(b, n_ctx, DIFF_HEADS, 2 * DIFF_HEAD_DIM)
    k1 = jnp.concatenate([kc_a[..., 0, :], k_a[..., 0, :]], axis=1)
    k2 = jnp.concatenate([kc_a[..., 1, :], k_a[..., 1, :]], axis=1)
    v_all_a = jnp.concatenate([vc_a, v_a], axis=1)
    lam_init = 0.8 - 0.6 * math.exp(-0.3 * layer_idx)
    f32 = jnp.float32
    lam = (jnp.exp(jnp.sum(p['lambda_q1'].astype(f32) * p['lambda_k1'].astype(f32)))
           - jnp.exp(jnp.sum(p['lambda_q2'].astype(f32) * p['lambda_k2'].astype(f32))) + lam_init)
    o_a = diff_attention(q_a[..., 0, :], q_a[..., 1, :], k1, k2, v_all_a, lam)
    o_a = (rms_norm(o_a, p['subln']) * (1.0 - lam_init)).reshape(b, s, DIFF_HEADS * 2 * DIFF_HEAD_DIM)

    q_b = rms_norm(proj[..., OFF_BQ:OFF_BK].reshape(b, s, GQA_HEADS, GQA_HEAD_DIM), p['q_norm'])
    q_b = apply_rope(q_b, cos, sin)
    k_b = rms_norm(proj[..., OFF_BK:OFF_BV].reshape(b, s, GQA_KV_HEADS, GQA_HEAD_DIM), p['k_norm'])
    k_b = apply_rope(k_b, cos, sin)
    v_b = proj[..., OFF_BV:IN_WIDTH].reshape(b, s, GQA_KV_HEADS, GQA_HEAD_DIM)
    kc_b = rms_norm(ctx_b[..., :B_K_W].reshape(b, n_ctx, GQA_KV_HEADS, GQA_HEAD_DIM), p['k_norm'])
    vc_b = ctx_b[..., B_K_W:].reshape(b, n_ctx, GQA_KV_HEADS, GQA_HEAD_DIM)
    o_b = gqa_attention(q_b, jnp.concatenate([kc_b, k_b], axis=1), jnp.concatenate([vc_b, v_b], axis=1))
    o_b = o_b.reshape(b, s, GQA_HEADS * GQA_HEAD_DIM)

    y = jnp.concatenate([o_a, o_b], axis=-1) @ p['w_out']
    return x + gate * y


def fourier_mixer(x, mod, p):
    b, s, d = x.shape
    shift, scale, gate = mod
    h = modulate(rms_norm(x, p['norm_mix']), shift, scale)
    hg = h.reshape(b, s, FOURIER_GROUPS, FOURIER_GROUP_DIM).astype(jnp.float32)
    f = jnp.fft.fft2(hg, axes=(1, 3), norm='ortho').real.astype(h.dtype).reshape(b, s, d)
    return x + gate * (f @ p['w_out'])


def swiglu_ffn(x, mod, p):
    shift, scale, gate = mod
    h = modulate(rms_norm(x, p['norm_ffn']), shift, scale)
    g, u = jnp.split(h @ p['w_gate_up'], 2, axis=-1)
    return x + gate * ((jax.nn.silu(g) * u) @ p['w_down'])


def setup_inputs(seed: int = 0) -> dict:
    key = jax.random.key(seed)
    ks = iter(jax.random.split(key, 32))

    def nrm(shape, scale):
        return jax.random.normal(next(ks), shape, jnp.float32) * scale

    def gain(n):
        return 1.0 + nrm((n,), 0.05)

    fan = D_MODEL ** -0.5
    inp = {
        'x': nrm((BATCH, SEQ, D_MODEL), 1.0),
        'c': nrm((BATCH, D_MODEL), 1.0),
        'ctx': nrm((BATCH, CTX_LEN, D_MODEL), 1.0),
        'c_ctx': nrm((D_MODEL,), 1.0),
        'l0_ada_w': nrm((D_MODEL, N_MOD * D_MODEL), 0.5 * fan),
        'l0_ada_b': nrm((N_MOD * D_MODEL,), 0.02),
        'l0_norm_mix': gain(D_MODEL),
        'l0_w_in': nrm((D_MODEL, IN_WIDTH), fan),
        'l0_lambda_q1': nrm((DIFF_HEAD_DIM,), 0.1),
        'l0_lambda_k1': nrm((DIFF_HEAD_DIM,), 0.1),
        'l0_lambda_q2': nrm((DIFF_HEAD_DIM,), 0.1),
        'l0_lambda_k2': nrm((DIFF_HEAD_DIM,), 0.1),
        'l0_subln': gain(2 * DIFF_HEAD_DIM),
        'l0_q_norm': gain(GQA_HEAD_DIM),
        'l0_k_norm': gain(GQA_HEAD_DIM),
        'l0_w_out': nrm((MIX_WIDTH, D_MODEL), MIX_WIDTH ** -0.5),
        'l0_norm_ffn': gain(D_MODEL),
        'l0_w_gate_up': nrm((D_MODEL, 2 * D_FF), fan),
        'l0_w_down': nrm((D_FF, D_MODEL), D_FF ** -0.5),
        'l1_ada_w': nrm((D_MODEL, N_MOD * D_MODEL), 0.5 * fan),
        'l1_ada_b': nrm((N_MOD * D_MODEL,), 0.02),
        'l1_norm_mix': gain(D_MODEL),
        'l1_w_out': nrm((D_MODEL, D_MODEL), fan),
        'l1_norm_ffn': gain(D_MODEL),
        'l1_w_gate_up': nrm((D_MODEL, 2 * D_FF), fan),
        'l1_w_down': nrm((D_FF, D_MODEL), D_FF ** -0.5),
        'final_norm': gain(D_MODEL),
    }
    return inp


def reference(x, c, ctx, c_ctx,
              l0_ada_w, l0_ada_b, l0_norm_mix, l0_w_in, l0_lambda_q1, l0_lambda_k1, l0_lambda_q2, l0_lambda_k2,
              l0_subln, l0_q_norm, l0_k_norm, l0_w_out, l0_norm_ffn, l0_w_gate_up, l0_w_down,
              l1_ada_w, l1_ada_b, l1_norm_mix, l1_w_out, l1_norm_ffn, l1_w_gate_up, l1_w_down,
              final_norm):
    layers = [
        dict(ada_w=l0_ada_w, ada_b=l0_ada_b, norm_mix=l0_norm_mix, w_in=l0_w_in,
             lambda_q1=l0_lambda_q1, lambda_k1=l0_lambda_k1, lambda_q2=l0_lambda_q2, lambda_k2=l0_lambda_k2,
             subln=l0_subln, q_norm=l0_q_norm, k_norm=l0_k_norm, w_out=l0_w_out,
             norm_ffn=l0_norm_ffn, w_gate_up=l0_w_gate_up, w_down=l0_w_down),
        dict(ada_w=l1_ada_w, ada_b=l1_ada_b, norm_mix=l1_norm_mix, w_out=l1_w_out,
             norm_ffn=l1_norm_ffn, w_gate_up=l1_w_gate_up, w_down=l1_w_down),
    ]
    cos, sin = rope_tables(x.shape[1])
    for l in range(DEPTH):
        p = layers[l]
        mod = ada_params(c, p['ada_w'], p['ada_b'])
        if l % 2 == 0:
            mod_c = ada_params(c_ctx[None], p['ada_w'], p['ada_b'])
            x = attention_mixer(x, ctx, cos, sin, mod[0:3], (mod_c[0], mod_c[1]), p, l)
        else:
            x = fourier_mixer(x, mod[0:3], p)
        x = swiglu_ffn(x, mod[3:6], p)
    return rms_norm(x, final_norm)
```

```cpp
#include <hip/hip_runtime.h>
#include <hip/hip_cooperative_groups.h>
#include <hip/hip_bf16.h>
#include <cstdio>
#include <cstdint>
#include <cmath>
namespace pg8 {
#define PG8_LAS __attribute__((address_space(3)))
typedef unsigned short bf16_t;
typedef short bf16x8 __attribute__((ext_vector_type(8)));
typedef float f32x4 __attribute__((ext_vector_type(4)));
typedef unsigned u32x4 __attribute__((ext_vector_type(4)));
constexpr int BM = 256, BK = 64, HALF = 128, HTB = HALF * BK * 2  , STAGE_BYTES = 8 * HTB, NXCD = 8, WGM = 8;

__host__ __device__ __forceinline__ int lds_byte(int r, int c) { const int st = (r >> 4) * 2 + (c >> 5), rr = r & 15, cc = c & 31, ob = rr * 64 + cc * 2; return st * 1024 + (ob ^ (((ob >> 9) & 1) << 5)); }
__host__ __device__ __forceinline__ void stage_rc(int b, int& R, int& C) { const int st = b / 1024, sb = b % 1024, swz = sb ^ (((sb >> 9) & 1) << 5); R = (st >> 1) * 16 + swz / 64; C = (st & 1) * 32 + (swz % 64) / 2; }
__host__ __device__ __forceinline__ int perm32(int rho) { const int n = rho >> 4, i = rho & 15; return 8 * (i >> 2) + 4 * n + (i & 3); }
struct Unit { int pm, pn; };
struct Gemm { const bf16_t* A; const bf16_t* Bt; int M, N, K; };

struct StaticOrder {
    int nM, nN, nwg, G, c;
    __host__ __device__ void init(int M, int N, int G_, int c_) { nM = M / BM; nN = N / BM; nwg = nM * nN; G = G_; c = c_; }
    __host__ __device__ bool next(int i, Unit& u) const {
        const long L = (long)i * G + c; if (L >= nwg) return false;
        int wgid = (int)L; { const int q = nwg / NXCD, r = nwg % NXCD, xcd = wgid % NXCD, off = wgid / NXCD; wgid = (xcd < r ? xcd * (q + 1) : r * (q + 1) + (xcd - r) * q) + off; }
        const int nig = WGM * nN, gid = wgid / nig, fm = gid * WGM, gsz = (nM - fm) < WGM ? (nM - fm) : WGM;
        u.pm = fm + ((wgid % nig) % gsz); u.pn = (wgid % nig) / gsz; return true;
    }
    __device__ __forceinline__ void a_ready(const Unit&) const {}
    __device__ __forceinline__ void done(const Unit&) const {}
};
__device__ __forceinline__ unsigned cvt_pk_bf16(float lo, float hi) { unsigned r; asm volatile("v_cvt_pk_bf16_f32 %0, %1, %2" : "=v"(r) : "v"(lo), "v"(hi)); return r; }
typedef float f32x2 __attribute__((ext_vector_type(2)));
struct GemmStd { const bf16_t* A; const bf16_t* Bt; int K, lda, ldb;
    __device__ __forceinline__ const char* aptr(const Unit& u) const { return (const char*)A + (size_t)u.pm * BM * lda * 2; }
    __device__ __forceinline__ const char* bptr(const Unit& u) const { return (const char*)Bt + (size_t)u.pn * BM * ldb * 2; } };
struct GemmF1 { const bf16_t* A; const bf16_t* Bt; int K, lda, ldb;
    __device__ __forceinline__ const char* aptr(const Unit&) const { return (const char*)A; }
    __device__ __forceinline__ const char* bptr(const Unit& u) const { return (const char*)Bt + ((size_t)((u.pm >> 3) * 2048 + u.pn * 256) * 1024 + (size_t)(u.pm & 7) * 128) * 2; } };
struct GemmF2 { const bf16_t* A; const bf16_t* Bt; int K, lda, ldb;
    __device__ __forceinline__ const char* aptr(const Unit& u) const { return (const char*)A + (size_t)(u.pm & 7) * 256 * 4096 * 2; }
    __device__ __forceinline__ const char* bptr(const Unit& u) const { return (const char*)Bt + ((size_t)(u.pm >> 3) * 1024 + (size_t)u.pn * 256) * 4096 * 2; } };

struct EpiBf16 {
    static constexpr bool PERM = true, AFTER_DRAIN = false;
    bf16_t* O; int ldc;
    __device__ __forceinline__ void operator()(const f32x4 (&acc)[2][2][4][2], const Unit& u, int wr, int wc, int fr, int fq) const {
        const int row0 = u.pm * BM + wr * 64 + fr, col0 = u.pn * BM + wc * 32 + 8 * fq;
#pragma unroll
        for (int ai = 0; ai < 2; ++ai)
#pragma unroll
            for (int m = 0; m < 4; ++m) { bf16_t* rowp = O + (size_t)(row0 + ai * HALF + m * 16) * ldc + col0;
#pragma unroll
                for (int bj = 0; bj < 2; ++bj) { const f32x4 v0 = acc[ai][bj][m][0], v1 = acc[ai][bj][m][1];
                    u32x4 w; w.x = cvt_pk_bf16(v0[0], v0[1]); w.y = cvt_pk_bf16(v0[2], v0[3]); w.z = cvt_pk_bf16(v1[0], v1[1]); w.w = cvt_pk_bf16(v1[2], v1[3]);
                    *(u32x4*)(rowp + bj * HALF) = w; } }
    }
};
struct EpiF1 {
    static constexpr bool PERM = true, AFTER_DRAIN = false;
    bf16_t* YT;
    __device__ __forceinline__ void operator()(const f32x4 (&acc)[2][2][4][2], const Unit& u, int wr, int wc, int fr, int fq) const {
        const int b = u.pm >> 3, g = u.pm & 7; const float sc = 1.0f / 512.0f;
        const int col0 = u.pn * BM + wc * 32 + 8 * fq;
#pragma unroll
        for (int ai = 0; ai < 2; ++ai)
#pragma unroll
            for (int m = 0; m < 4; ++m) { bf16_t* rowp = YT + ((size_t)(b * 1024 + g * 128 + wr * 64 + m * 16 + fr)) * 4096 + ai * 2048 + col0;
#pragma unroll
                for (int bj = 0; bj < 2; ++bj) { const f32x4 v0 = acc[ai][bj][m][0] * sc, v1 = acc[ai][bj][m][1] * sc;
                    u32x4 w; w.x = cvt_pk_bf16(v0[0], v0[1]); w.y = cvt_pk_bf16(v0[2], v0[3]); w.z = cvt_pk_bf16(v1[0], v1[1]); w.w = cvt_pk_bf16(v1[2], v1[3]);
                    *(u32x4*)(rowp + bj * HALF) = w; }
                asm volatile("" ::: "memory"); }
    }
};
__device__ __forceinline__ float silu_mul(float g, float u) { return g * u * __builtin_amdgcn_rcpf(1.0f + __builtin_amdgcn_exp2f(-1.4426950408889634f * g)); }
struct EpiSwiglu {
    static constexpr bool PERM = true, AFTER_DRAIN = false;
    bf16_t* O; int ldc;
    __device__ __forceinline__ void operator()(const f32x4 (&acc)[2][2][4][2], const Unit& u, int wr, int wc, int fr, int fq) const {
        const int row0 = u.pm * BM + wr * 64 + fr, col0 = u.pn * HALF + wc * 32 + 8 * fq;
#pragma unroll
        for (int ai = 0; ai < 2; ++ai)
#pragma unroll
            for (int m = 0; m < 4; ++m) { bf16_t* rowp = O + (size_t)(row0 + ai * HALF + m * 16) * ldc + col0;
                const f32x4 g0 = acc[ai][0][m][0], g1 = acc[ai][0][m][1], u0 = acc[ai][1][m][0], u1 = acc[ai][1][m][1];
                u32x4 w; w.x = cvt_pk_bf16(silu_mul(g0[0], u0[0]), silu_mul(g0[1], u0[1])); w.y = cvt_pk_bf16(silu_mul(g0[2], u0[2]), silu_mul(g0[3], u0[3]));
                w.z = cvt_pk_bf16(silu_mul(g1[0], u1[0]), silu_mul(g1[1], u1[1])); w.w = cvt_pk_bf16(silu_mul(g1[2], u1[2]), silu_mul(g1[3], u1[3]));
                *(u32x4*)rowp = w; }
    }
};
struct EpiResGate {
    static constexpr bool PERM = false, AFTER_DRAIN = false;
    const float* base; float* out; const float* gate; int gstride;
    __device__ __forceinline__ void operator()(const f32x4 (&acc)[2][2][4][2], const Unit& u, int wr, int wc, int fr, int fq) const {
        const int col0 = u.pn * BM + wc * 32 + 4 * fq; const float* gp = gate + (size_t)(u.pm >> 3) * gstride + col0;
        f32x4 gv[2][2];
#pragma unroll
        for (int bj = 0; bj < 2; ++bj)
#pragma unroll
            for (int n = 0; n < 2; ++n) gv[bj][n] = *(const f32x4*)(gp + bj * HALF + n * 16);
#pragma unroll
        for (int ai = 0; ai < 2; ++ai)
#pragma unroll
            for (int m = 0; m < 4; ++m) { const size_t off = (size_t)(u.pm * BM + ai * HALF + wr * 64 + m * 16 + fr) * 1024 + col0;
#pragma unroll
                for (int bj = 0; bj < 2; ++bj)
#pragma unroll
                    for (int n = 0; n < 2; ++n) { const f32x4 bs = *(const f32x4*)(base + off + bj * HALF + n * 16); *(f32x4*)(out + off + bj * HALF + n * 16) = bs + gv[bj][n] * acc[ai][bj][m][n]; }
                if (m & 1) asm volatile("" ::: "memory"); }
    }
};
template <class Epi, class G, class Sched, bool ALIGN_EPI = false, bool SP2 = false>
__device__ __forceinline__ void gemm_phase(PG8_LAS unsigned char* lds, const G g, const Sched& S, const Epi& E) {
    const int tid = threadIdx.x, wid = __builtin_amdgcn_readfirstlane(tid >> 6), lane = tid & 63, wr = wid >> 2, wc = wid & 3, fr = lane & 15, fq = lane >> 4;
    const int K = g.K, nt = K / BK;
    unsigned voffA[2], voffB[2];
#pragma unroll
    for (int i = 0; i < 2; ++i) { int R, C; stage_rc(tid * 16 + i * 8192, R, C); const int Rb = Epi::PERM ? ((R & ~31) + perm32(R & 31)) : R;
        voffA[i] = (unsigned)(R * g.lda + C) * 2u; voffB[i] = (unsigned)(Rb * g.ldb + C) * 2u; }
    const size_t kstep = (size_t)(BK * 2);
    const size_t hstepA = (size_t)HALF * g.lda * 2, hstepB = (size_t)HALF * g.ldb * 2;
    const unsigned ldsw = (unsigned)wid * 1024u;
    const int aoff = lds_byte(wr * 64 + fr, fq * 8), boff = lds_byte(wc * 32 + fr, fq * 8);
#define PG8_SA(b, h) (((b) * 2 + (h)) * HTB)
#define PG8_SB(b, h) ((4 + (b) * 2 + (h)) * HTB)
#define PG8_STAGE(bufoff, gbase, voff) do { _Pragma("unroll") for (int _i = 0; _i < 2; ++_i) \
        __builtin_amdgcn_global_load_lds((const unsigned*)((const char*)(gbase) + (voff)[_i]), (PG8_LAS unsigned*)(lds + (bufoff) + ldsw + _i * 8192), 16, 0, 0); } while (0)
#define PG8_LDA(dst, b, h) do { _Pragma("unroll") for (int m = 0; m < 4; ++m) _Pragma("unroll") for (int k = 0; k < 2; ++k) dst[m][k] = *(const PG8_LAS bf16x8*)(lds + PG8_SA(b, h) + aoff + m * 2048 + k * 1024); } while (0)
#define PG8_LDB(dst, b, h) do { _Pragma("unroll") for (int n = 0; n < 2; ++n) _Pragma("unroll") for (int k = 0; k < 2; ++k) dst[n][k] = *(const PG8_LAS bf16x8*)(lds + PG8_SB(b, h) + boff + n * 2048 + k * 1024); } while (0)
#define PG8_MMA(ai, bj, At, Bt) do { __builtin_amdgcn_s_setprio(1); _Pragma("unroll") for (int m = 0; m < 4; ++m) _Pragma("unroll") for (int n = 0; n < 2; ++n) _Pragma("unroll") for (int k = 0; k < 2; ++k) \
        acc[ai][bj][m][n] = __builtin_amdgcn_mfma_f32_16x16x32_bf16(Bt[n][k], At[m][k], acc[ai][bj][m][n], 0, 0, 0); __builtin_amdgcn_s_setprio(0); } while (0)
#define PG8_WAIT_V(n) asm volatile("s_waitcnt vmcnt(" #n ")" ::: "memory")
#define PG8_WAIT_L(n) asm volatile("s_waitcnt lgkmcnt(" #n ")" ::: "memory")
#define PG8_BAR __builtin_amdgcn_s_barrier()
#define PG8_SCHED __builtin_amdgcn_sched_barrier(0)
    Unit cur, nxt; int ui = 0;
    if (!S.next(0, cur)) return;
    f32x4 acc[2][2][4][2];
#pragma unroll
    for (int a = 0; a < 2; ++a)
#pragma unroll
        for (int b = 0; b < 2; ++b)
#pragma unroll
            for (int m = 0; m < 4; ++m)
#pragma unroll
                for (int n = 0; n < 2; ++n) acc[a][b][m][n] = (f32x4){0.f, 0.f, 0.f, 0.f};
    bf16x8 At[4][2], B0[2][2], B1[2][2];
    const char* cA = g.aptr(cur); const char* cB = g.bptr(cur);
    S.a_ready(cur);
    if constexpr (SP2) {
        PG8_STAGE(PG8_SB(0, 0), cB, voffB); PG8_STAGE(PG8_SB(0, 1), cB + hstepB, voffB); PG8_STAGE(PG8_SA(0, 0), cA, voffA); PG8_STAGE(PG8_SA(0, 1), cA + hstepA, voffA);
        if (wr == 1) PG8_BAR;
        PG8_WAIT_V(2); PG8_BAR;
        PG8_STAGE(PG8_SB(1, 0), cB + kstep, voffB); PG8_STAGE(PG8_SA(1, 0), cA + kstep, voffA); PG8_STAGE(PG8_SB(1, 1), cB + hstepB + kstep, voffB);
        PG8_WAIT_V(6); PG8_BAR;
    } else {
        PG8_STAGE(PG8_SB(0, 0), cB, voffB); PG8_STAGE(PG8_SA(0, 0), cA, voffA); PG8_STAGE(PG8_SB(0, 1), cB + hstepB, voffB); PG8_STAGE(PG8_SA(0, 1), cA + hstepA, voffA);
        if (wr == 1) PG8_BAR;
        PG8_WAIT_V(4); PG8_BAR;
        PG8_STAGE(PG8_SB(1, 0), cB + kstep, voffB); PG8_STAGE(PG8_SA(1, 0), cA + kstep, voffA); PG8_STAGE(PG8_SB(1, 1), cB + hstepB + kstep, voffB);
        PG8_WAIT_V(6); PG8_BAR;
    }
    for (;;) {
        const bool has_next = S.next(ui + 1, nxt);
        const char* nA = has_next ? g.aptr(nxt) : cA; const char* nB = has_next ? g.bptr(nxt) : cB;
        for (int t = 0; t < nt; t += 2) {
            const bool last = (t == nt - 2);
            const char* a1 = cA + (size_t)(t + 1) * kstep;
            const char* a2 = last ? nA : cA + (size_t)(t + 2) * kstep; const char* b2 = last ? nB : cB + (size_t)(t + 2) * kstep;
            const char* a3 = a2 + kstep; const char* b3 = b2 + kstep;
            if (last && has_next) S.a_ready(nxt);
            if constexpr (SP2) {
            PG8_LDB(B0, 0, 0); PG8_LDB(B1, 0, 1); PG8_SCHED; PG8_LDA(At, 0, 0); PG8_STAGE(PG8_SA(1, 1), a1 + hstepA, voffA);
            PG8_WAIT_V(8); PG8_WAIT_L(0); PG8_BAR; PG8_MMA(0, 0, At, B0); PG8_MMA(0, 1, At, B1); PG8_BAR; PG8_SCHED;
            PG8_LDA(At, 0, 1); PG8_STAGE(PG8_SB(0, 0), b2, voffB); PG8_STAGE(PG8_SB(0, 1), b2 + hstepB, voffB); PG8_STAGE(PG8_SA(0, 0), a2, voffA);
            PG8_WAIT_V(8); PG8_WAIT_L(0); PG8_BAR; PG8_MMA(1, 0, At, B0); PG8_MMA(1, 1, At, B1); PG8_BAR; PG8_SCHED;
            PG8_LDB(B0, 1, 0); PG8_LDB(B1, 1, 1); PG8_SCHED; PG8_LDA(At, 1, 0); PG8_STAGE(PG8_SA(0, 1), a2 + hstepA, voffA);
            PG8_WAIT_V(8); PG8_WAIT_L(0); PG8_BAR; PG8_MMA(0, 0, At, B0); PG8_MMA(0, 1, At, B1); PG8_BAR; PG8_SCHED;
            PG8_LDA(At, 1, 1); PG8_STAGE(PG8_SB(1, 0), b3, voffB); PG8_STAGE(PG8_SB(1, 1), b3 + hstepB, voffB); PG8_STAGE(PG8_SA(1, 0), a3, voffA);
            PG8_WAIT_V(8); PG8_WAIT_L(0); PG8_BAR; PG8_MMA(1, 0, At, B0); PG8_MMA(1, 1, At, B1); PG8_BAR; PG8_SCHED;
            } else {
            PG8_LDB(B0, 0, 0); PG8_SCHED; PG8_LDA(At, 0, 0); PG8_STAGE(PG8_SA(1, 1), a1 + hstepA, voffA);
            PG8_WAIT_L(8); PG8_BAR; PG8_WAIT_L(0); PG8_MMA(0, 0, At, B0); PG8_BAR; PG8_SCHED;
            PG8_LDB(B1, 0, 1); PG8_STAGE(PG8_SB(0, 0), b2, voffB);
            PG8_BAR; PG8_WAIT_L(0); PG8_MMA(0, 1, At, B1); PG8_BAR;
            PG8_LDA(At, 0, 1); PG8_STAGE(PG8_SA(0, 0), a2, voffA);
            PG8_BAR; PG8_WAIT_L(0); PG8_MMA(1, 0, At, B0); PG8_BAR; PG8_SCHED;
            PG8_STAGE(PG8_SB(0, 1), b2 + hstepB, voffB);
            PG8_WAIT_V(6); PG8_BAR; PG8_MMA(1, 1, At, B1); PG8_BAR;
            PG8_LDB(B0, 1, 0); PG8_SCHED; PG8_LDA(At, 1, 0); PG8_STAGE(PG8_SA(0, 1), a2 + hstepA, voffA);
            PG8_WAIT_L(8); PG8_BAR; PG8_WAIT_L(0); PG8_MMA(0, 0, At, B0); PG8_BAR; PG8_SCHED;
            PG8_LDB(B1, 1, 1); PG8_STAGE(PG8_SB(1, 0), b3, voffB);
            PG8_BAR; PG8_WAIT_L(0); PG8_MMA(0, 1, At, B1); PG8_BAR;
            PG8_LDA(At, 1, 1); PG8_STAGE(PG8_SA(1, 0), a3, voffA);
            PG8_BAR; PG8_WAIT_L(0); PG8_MMA(1, 0, At, B0); PG8_BAR; PG8_SCHED;
            PG8_STAGE(PG8_SB(1, 1), b3 + hstepB, voffB);
            PG8_WAIT_V(6); PG8_BAR; PG8_MMA(1, 1, At, B1); PG8_BAR;
            }
        }
        if constexpr (ALIGN_EPI) { if (wr == 0) PG8_BAR; }
        if constexpr (!Epi::AFTER_DRAIN) { E(acc, cur, wr, wc, fr, fq); S.done(cur); }
        if (!has_next) break;
#pragma unroll
        for (int a = 0; a < 2; ++a)
#pragma unroll
            for (int b = 0; b < 2; ++b)
#pragma unroll
                for (int m = 0; m < 4; ++m)
#pragma unroll
                    for (int n = 0; n < 2; ++n) acc[a][b][m][n] = (f32x4){0.f, 0.f, 0.f, 0.f};
        cur = nxt; cA = nA; cB = nB; ++ui;
        if constexpr (ALIGN_EPI) { if (wr == 1) PG8_BAR; }
    }
    PG8_WAIT_V(0);
    if constexpr (!ALIGN_EPI) { if (wr == 0) PG8_BAR; }
    PG8_BAR;
    if constexpr (Epi::AFTER_DRAIN) { E.fused(acc, cur, wr, wc, fr, fq, lds, wid, lane); S.done(cur); }
#undef PG8_SA
#undef PG8_SB
#undef PG8_STAGE
#undef PG8_LDA
#undef PG8_LDB
#undef PG8_MMA
#undef PG8_WAIT_V
#undef PG8_WAIT_L
#undef PG8_BAR
#undef PG8_SCHED
}
}
namespace attn_body {
using bf16=__hip_bfloat16;
using bf16x8=__attribute__((ext_vector_type(8)))short;
using s16x4=__attribute__((ext_vector_type(4)))short;
using f32x16=__attribute__((ext_vector_type(16)))float;
using u32x4=__attribute__((ext_vector_type(4)))unsigned;
constexpr int D=64,DM=2304,NKEYS=2304;
constexpr int NW=8,QBLK=32,QB=QBLK*NW,KVBLK=64;
__device__ __forceinline__ int crow(int r,int hi){return (r&3)+8*(r>>2)+4*hi;}
#define SBAR() __builtin_amdgcn_sched_barrier(0)
__device__ __forceinline__ void cmask(f32x16&p0,f32x16&p1,int jb,int qrel,int hi){
  const float NEG=-INFINITY; int kb=64*jb+4*hi;
  #pragma unroll
  for(int r=0;r<16;++r){int kv=kb+(r&3)+8*(r>>2); if(kv>qrel)p0[r]=NEG; if(kv+32>qrel)p1[r]=NEG;}
}

constexpr int NSLOT=3, SLOTB=8192;
constexpr int LDS_K=0, LDS_V=NSLOT*SLOTB, LDS_WS=2*NSLOT*SLOTB, LDS_OST=LDS_WS+NW*64*4, LDS_BYTES=LDS_OST+NW*4096;
constexpr float C2=0.125f*1.4426950408889634f;
__device__ __forceinline__ void glds16(const void*gsrc,unsigned lds_dst){unsigned keep;
  asm volatile("s_mov_b32 %0, m0\n\ts_mov_b32 m0, %2\n\ts_nop 0\n\tglobal_load_lds_dwordx4 %1, off\n\ts_mov_b32 m0, %0":"=&s"(keep):"v"(gsrc),"s"(lds_dst):"memory");}
__device__ __forceinline__ float max3f(float a,float b,float c){float r;asm("v_max3_f32 %0, %1, %2, %3":"=v"(r):"v"(a),"v"(b),"v"(c));return r;}
__device__ __forceinline__ float max2f(float a,float b){float r;asm("v_max_f32_e32 %0, %1, %2":"=v"(r):"v"(a),"v"(b));return r;}
__device__ __forceinline__ float fadd_s(float a,float b){float r;asm("v_add_f32_e32 %0, %1, %2":"=v"(r):"v"(a),"v"(b));return r;}
__device__ __forceinline__ float fsub_s(float a,float b){float r;asm("v_sub_f32_e32 %0, %1, %2":"=v"(r):"v"(a),"v"(b));return r;}
typedef float f32x2_t __attribute__((ext_vector_type(2))); typedef __bf16 bf16x2_t __attribute__((ext_vector_type(2)));
__device__ __forceinline__ unsigned cvtpk_s(float lo,float hi){f32x2_t v={lo,hi};bf16x2_t b=__builtin_convertvector(v,bf16x2_t);return __builtin_bit_cast(unsigned,b);}
#define WAIT_BAR(N) asm volatile("s_waitcnt vmcnt(" #N ") lgkmcnt(0)\n\ts_barrier":::"memory")

__device__ __forceinline__ void qkt(f32x16&p0,f32x16&p1,const char*Kslot,const bf16x8*qr,const f32x16&negm,int r32,int hi){
  const char*kb=Kslot+hi*1024+r32*16;
  #pragma unroll
  for(int d0=0;d0<4;++d0){
    const bf16x8 b0=*reinterpret_cast<const bf16x8*>(kb+d0*2048);
    const bf16x8 b1=*reinterpret_cast<const bf16x8*>(kb+d0*2048+512);
    if(d0==0){p0=__builtin_amdgcn_mfma_f32_32x32x16_bf16(b0,qr[0],negm,0,0,0);p1=__builtin_amdgcn_mfma_f32_32x32x16_bf16(b1,qr[0],negm,0,0,0);}
    else{p0=__builtin_amdgcn_mfma_f32_32x32x16_bf16(b0,qr[d0],p0,0,0,0);p1=__builtin_amdgcn_mfma_f32_32x32x16_bf16(b1,qr[d0],p1,0,0,0);}}
}
typedef __attribute__((address_space(3))) const char* lds_cptr;
typedef short v4i16_t __attribute__((ext_vector_type(4)));
__device__ __forceinline__ void kload8(bf16x8*kf,lds_cptr kp){
  kf[0]=*(const __attribute__((address_space(3))) bf16x8*)(kp);      kf[1]=*(const __attribute__((address_space(3))) bf16x8*)(kp+512);
  kf[2]=*(const __attribute__((address_space(3))) bf16x8*)(kp+2048); kf[3]=*(const __attribute__((address_space(3))) bf16x8*)(kp+2560);
  kf[4]=*(const __attribute__((address_space(3))) bf16x8*)(kp+4096); kf[5]=*(const __attribute__((address_space(3))) bf16x8*)(kp+4608);
  kf[6]=*(const __attribute__((address_space(3))) bf16x8*)(kp+6144); kf[7]=*(const __attribute__((address_space(3))) bf16x8*)(kp+6656);
}
__device__ __forceinline__ void kload2(bf16x8*kf,lds_cptr kp,int j){ kf[2*j]=*(const __attribute__((address_space(3))) bf16x8*)(kp+j*2048); kf[2*j+1]=*(const __attribute__((address_space(3))) bf16x8*)(kp+j*2048+512); }
__device__ __forceinline__ s16x4 vtr(lds_cptr p){ return __builtin_bit_cast(s16x4,__builtin_amdgcn_ds_read_tr16_b64_v4i16((__attribute__((address_space(3))) v4i16_t*)p)); }
__device__ __forceinline__ float rowmax(const f32x16&p0,const f32x16&p1){
  float a=max3f(p0[0],p0[1],p1[0]),b=max3f(p0[2],p0[3],p1[1]);a=max3f(a,p1[2],p1[3]);
  #pragma unroll
  for(int r=4;r<16;r+=4){a=max3f(a,p0[r],p0[r+1]);b=max3f(b,p0[r+2],p0[r+3]);a=max3f(a,p1[r],p1[r+1]);b=max3f(b,p1[r+2],p1[r+3]);}
  const float m=max2f(a,b);
  auto rr=__builtin_amdgcn_permlane32_swap(__float_as_uint(m),__float_as_uint(m),false,false);
  return max2f(__uint_as_float(rr[0]),__uint_as_float(rr[1]));
}
__device__ __forceinline__ void pv(f32x16*o,int vb,bf16x8 pa0,bf16x8 pa1,bf16x8 pa2,bf16x8 pa3){
  #pragma unroll
  for(int d0=0;d0<2;++d0){s16x4 lo[4],hi[4];
    #pragma unroll
    for(int ks=0;ks<4;++ks){
      asm volatile("ds_read_b64_tr_b16 %0,%1 offset:%c2":"=&v"(lo[ks]):"v"(vb),"i"(d0*4096+ks*1024):"memory");
      asm volatile("ds_read_b64_tr_b16 %0,%1 offset:%c2":"=&v"(hi[ks]):"v"(vb),"i"(d0*4096+ks*1024+512):"memory");}
    asm volatile("s_waitcnt lgkmcnt(0)":::"memory");SBAR();
    #define PK(k) (bf16x8){lo[k][0],lo[k][1],lo[k][2],lo[k][3],hi[k][0],hi[k][1],hi[k][2],hi[k][3]}
    o[d0]=__builtin_amdgcn_mfma_f32_32x32x16_bf16(pa0,PK(0),o[d0],0,0,0);
    o[d0]=__builtin_amdgcn_mfma_f32_32x32x16_bf16(pa1,PK(1),o[d0],0,0,0);
    o[d0]=__builtin_amdgcn_mfma_f32_32x32x16_bf16(pa2,PK(2),o[d0],0,0,0);
    o[d0]=__builtin_amdgcn_mfma_f32_32x32x16_bf16(pa3,PK(3),o[d0],0,0,0);
    #undef PK
  }
}

#ifndef ATTN_STORE16
#define ATTN_STORE16(p,v) (*(u32x4*)(p)=(v))
#endif
template<int THRL> __device__ __forceinline__ void attn_unit(const bf16*Qb,const bf16*__restrict__ Kh,const bf16*__restrict__ Vh,bf16*Ob,char*shm){
  constexpr int opitch=1024;
  const int tid=threadIdx.x,lane=tid&63,r32=lane&31,hi=lane>>5; const int wid=__builtin_amdgcn_readfirstlane(tid>>6);
  const bf16*Qw=Qb+(long)(wid*QBLK)*DM;
  const unsigned lds0=(unsigned)(uintptr_t)shm;
  float*wsf=(float*)(shm+LDS_WS)+wid*64;
  const bf16*ksrc=Kh+(long)lane*DM+wid*8;
  const bf16*vsrc=Vh+(long)(16*(wid&3)+(lane>>2))*DM+(wid>>2)*32+(lane&3)*8;
  const unsigned kdst=lds0+LDS_K+wid*1024, vdst=lds0+LDS_V+wid*1024;
  #define DMA_K(t,slot) glds16(ksrc+(long)(t)*KVBLK*DM,(unsigned)__builtin_amdgcn_readfirstlane(kdst+(slot)))
  #define DMA_V(t,slot) glds16(vsrc+(long)(t)*KVBLK*DM,(unsigned)__builtin_amdgcn_readfirstlane(vdst+(slot)))
  const int vb0=(int)(lds0+LDS_V)+((lane>>4)&1)*32+(lane&3)*8+(4*hi+((lane&15)>>2))*64;
  const char*Kbase=shm+LDS_K; bf16x8 kf[8];
  const lds_cptr shm3=(lds_cptr)shm; const lds_cptr kp0=shm3+LDS_K+hi*1024+r32*16; const lds_cptr vp0=shm3+LDS_V+((lane>>4)&1)*32+(lane&3)*8+(4*hi+((lane&15)>>2))*64;
  const int NT=NKEYS/KVBLK;
  DMA_K(0,0);DMA_V(0,0);DMA_K(1,SLOTB);
  bf16x8 qr[4];
  #pragma unroll
  for(int d0=0;d0<4;++d0)qr[d0]=*reinterpret_cast<const bf16x8*>(&Qw[(long)r32*DM+d0*16+hi*8]);
  float mhat=0.f,l_reg=0.f;f32x16 o[2];o[0]=f32x16{};o[1]=f32x16{};f32x16 negm=f32x16{};asm volatile("":"+v"(negm));
  #define CMASK(P0,P1,t) do{}while(0)
  bool resc=false;
  #define START(P0,P1) do{ const float rm=rowmax(P0,P1); resc=false; \
    { const float dl=rm; mhat=fadd_s(mhat,dl); \
      _Pragma("unroll") for(int r=0;r<16;++r){P0[r]=fsub_s(P0[r],dl);P1[r]=fsub_s(P1[r],dl);} \
      _Pragma("unroll") for(int r=0;r<16;++r)negm[r]=-mhat; asm volatile("":"+v"(negm)); } \
    _Pragma("unroll") for(int r=0;r<16;++r)P0[r]=__builtin_amdgcn_exp2f(P0[r]); }while(0)
  #define RESC() do{ if(resc){ asm volatile("s_waitcnt lgkmcnt(0)":::"memory"); \
      _Pragma("unroll") for(int d_=0;d_<2;++d_) _Pragma("unroll") for(int r=0;r<16;++r)o[d_][r]*=wsf[crow(r,hi)]; } }while(0)
  f32x16 pA0,pA1,pB0,pB1;
  int sl_prev=0,sl_cur=0,sl_next=SLOTB;
  #define ROT() do{sl_prev=sl_cur;sl_cur=sl_next;sl_next=(sl_next==(NSLOT-1)*SLOTB)?0:sl_next+SLOTB;}while(0)
  DMA_K(2,2*SLOTB);
  WAIT_BAR(3);
  qkt(pA0,pA1,Kbase,qr,negm,r32,hi);asm volatile("s_nop 15\n\ts_nop 7":"+v"(pA0),"+v"(pA1));CMASK(pA0,pA1,0);
  START(pA0,pA1);
  _Pragma("unroll") for(int r=0;r<16;++r)pA1[r]=__builtin_amdgcn_exp2f(pA1[r]);
  WAIT_BAR(0);
  DMA_K(3,0);DMA_V(1,SLOTB);
  ROT();
  kload8(kf,kp0+sl_cur);
  WAIT_BAR(2);
  s16x4 vlo[8],vhi[8]; u32x4 pw0,pw1,pw2,pw3;
  #define PKW(P,B) cvtpk_s(P[B],P[B+1])
  #define PAF(k) __builtin_bit_cast(bf16x8,pw##k)
  #define VFR(i) (bf16x8){vlo[i][0],vlo[i][1],vlo[i][2],vlo[i][3],vhi[i][0],vhi[i][1],vhi[i][2],vhi[i][3]}
  #define PIN(x) asm volatile("":"+v"(x))
  #define MX3(a,b,c) __builtin_fmaxf(__builtin_fmaxf((a),(b)),(c))
  #define GAPA(MF,A0,A1,A2,A3,W0,W1,PW) do{ MF; sacc+=A0; sacc+=A1; sacc+=A2; sacc+=A3; PIN(sacc); W0; W1; PIN(PW); SBAR(); }while(0)
  #define EX(v) __builtin_amdgcn_exp2f(v)
  #define GAPB(MF,X,B) do{ MF; X[B]=EX(X[B]); X[B+1]=EX(X[B+1]); X[B+2]=EX(X[B+2]); X[B+3]=EX(X[B+3]); PIN(X); SBAR(); }while(0)
  #define VRD(i) do{ vlo[i]=vtr(vp_+(((i)>>2)*4096+((i)&3)*1024)); vhi[i]=vtr(vp_+(((i)>>2)*4096+((i)&3)*1024+512)); }while(0)
  #define KRD(G,j) do{ if(G){ kload2(kf,kp0+sl_next,j); SBAR(); } }while(0)
  #define STEP(C0,C1,P0,P1,t,GK,GV,GL) do{ SBAR(); \
    const lds_cptr vp_=vp0+sl_prev; \
    VRD(0); SBAR(); float sacc=(P0[0]+P0[1]); \
    GAPA(C0=__builtin_amdgcn_mfma_f32_32x32x16_bf16(kf[0],qr[0],negm,0,0,0), P0[2],P0[3],P0[4],P0[5],     pw0[0]=PKW(P0,0), pw0[1]=PKW(P0,2), pw0); \
    VRD(4); SBAR(); GAPA(C1=__builtin_amdgcn_mfma_f32_32x32x16_bf16(kf[1],qr[0],negm,0,0,0), P0[6],P0[7],P0[8],P0[9],     pw0[2]=PKW(P0,4), pw0[3]=PKW(P0,6), pw0); \
    VRD(1); SBAR(); GAPA(C0=__builtin_amdgcn_mfma_f32_32x32x16_bf16(kf[2],qr[1],C0,0,0,0),   P0[10],P0[11],P0[12],P0[13], pw1[0]=PKW(P0,8), pw1[1]=PKW(P0,10), pw1); \
    VRD(5); SBAR(); GAPA(C1=__builtin_amdgcn_mfma_f32_32x32x16_bf16(kf[3],qr[1],C1,0,0,0),   P0[14],P0[15],P1[0],P1[1],   pw1[2]=PKW(P0,12),pw1[3]=PKW(P0,14), pw1); \
    VRD(2); SBAR(); GAPA(C0=__builtin_amdgcn_mfma_f32_32x32x16_bf16(kf[4],qr[2],C0,0,0,0),   P1[2],P1[3],P1[4],P1[5],     pw2[0]=PKW(P1,0), pw2[1]=PKW(P1,2), pw2); \
    VRD(6); SBAR(); GAPA(C1=__builtin_amdgcn_mfma_f32_32x32x16_bf16(kf[5],qr[2],C1,0,0,0),   P1[6],P1[7],P1[8],P1[9],     pw2[2]=PKW(P1,4), pw2[3]=PKW(P1,6), pw2); \
    VRD(3); SBAR(); GAPA(C0=__builtin_amdgcn_mfma_f32_32x32x16_bf16(kf[6],qr[3],C0,0,0,0),   P1[10],P1[11],P1[12],P1[13], pw3[0]=PKW(P1,8), pw3[1]=PKW(P1,10), pw3); \
    VRD(7); SBAR(); GAPA(C1=__builtin_amdgcn_mfma_f32_32x32x16_bf16(kf[7],qr[3],C1,0,0,0),   P1[14],P1[15],0.f,0.f,       pw3[2]=PKW(P1,12),pw3[3]=PKW(P1,14), pw3); \
    l_reg+=sacc; \
    if(GK){DMA_K((t)+3,sl_cur);} if(GV){DMA_V((t)+1,sl_next);} \
    CMASK(C0,C1,t); \
    { float a=MX3(C0[0],C0[1],C1[0]),b=MX3(C0[2],C0[3],C1[1]); a=MX3(a,C1[2],C1[3]); \
      _Pragma("unroll") for(int r=4;r<16;r+=4){a=MX3(a,C0[r],C0[r+1]);b=MX3(b,C0[r+2],C0[r+3]);a=MX3(a,C1[r],C1[r+1]);b=MX3(b,C1[r+2],C1[r+3]);} \
      float rm=__builtin_fmaxf(a,b); { auto rr=__builtin_amdgcn_permlane32_swap(__float_as_uint(rm),__float_as_uint(rm),false,false); rm=__builtin_fmaxf(__uint_as_float(rr[0]),__uint_as_float(rr[1])); } \
      resc=false; \
      if(__builtin_expect(__any(rm>(float)THRL),0)){ const float dl=__builtin_fmaxf(rm,0.f); mhat+=dl; \
        _Pragma("unroll") for(int r=0;r<16;++r){C0[r]-=dl;C1[r]-=dl;} \
        _Pragma("unroll") for(int r=0;r<16;++r)negm[r]=-mhat; asm volatile("":"+v"(negm)); \
        const float f=__builtin_amdgcn_exp2f(-dl); l_reg*=f; if(hi==0)wsf[r32]=f; resc=true; } } \
    SBAR(); \
    GAPB(o[0]=__builtin_amdgcn_mfma_f32_32x32x16_bf16(PAF(0),VFR(0),o[0],0,0,0), C0,0); \
    GAPB(o[1]=__builtin_amdgcn_mfma_f32_32x32x16_bf16(PAF(0),VFR(4),o[1],0,0,0), C0,4); \
    KRD(GL,0); GAPB(o[0]=__builtin_amdgcn_mfma_f32_32x32x16_bf16(PAF(1),VFR(1),o[0],0,0,0), C0,8); \
    KRD(GL,1); GAPB(o[1]=__builtin_amdgcn_mfma_f32_32x32x16_bf16(PAF(1),VFR(5),o[1],0,0,0), C0,12); \
    KRD(GL,2); GAPB(o[0]=__builtin_amdgcn_mfma_f32_32x32x16_bf16(PAF(2),VFR(2),o[0],0,0,0), C1,0); \
    KRD(GL,3); GAPB(o[1]=__builtin_amdgcn_mfma_f32_32x32x16_bf16(PAF(2),VFR(6),o[1],0,0,0), C1,4); \
    GAPB(o[0]=__builtin_amdgcn_mfma_f32_32x32x16_bf16(PAF(3),VFR(3),o[0],0,0,0), C1,8); \
    GAPB(o[1]=__builtin_amdgcn_mfma_f32_32x32x16_bf16(PAF(3),VFR(7),o[1],0,0,0), C1,12); \
    }while(0)
  int t=1;
  for(;t+5<NT;t+=2){
    STEP(pB0,pB1,pA0,pA1,t,true,true,true);     WAIT_BAR(2); RESC(); ROT();
    STEP(pA0,pA1,pB0,pB1,t+1,true,true,true);   WAIT_BAR(2); RESC(); ROT();
  }
  #define ENDW(tt) do{ if((tt)+3<NT){WAIT_BAR(2);} else if((tt)+2<NT){WAIT_BAR(1);} else {WAIT_BAR(0);} }while(0)
  for(;t+1<NT;t+=2){
    STEP(pB0,pB1,pA0,pA1,t,(t+3<NT),(t+1<NT),(t+1<NT));       ENDW(t);   RESC(); ROT();
    STEP(pA0,pA1,pB0,pB1,t+1,(t+4<NT),(t+2<NT),(t+2<NT));     ENDW(t+1); RESC(); ROT();
  }
  STEP(pB0,pB1,pA0,pA1,NT-1,false,false,false); RESC();
  { float sacc=pB0[0]+pB0[1]; _Pragma("unroll") for(int r=2;r<16;++r)sacc+=pB0[r]; _Pragma("unroll") for(int r=0;r<16;++r)sacc+=pB1[r]; l_reg+=sacc;
    pw0=(u32x4){PKW(pB0,0),PKW(pB0,2),PKW(pB0,4),PKW(pB0,6)};pw1=(u32x4){PKW(pB0,8),PKW(pB0,10),PKW(pB0,12),PKW(pB0,14)};pw2=(u32x4){PKW(pB1,0),PKW(pB1,2),PKW(pB1,4),PKW(pB1,6)};pw3=(u32x4){PKW(pB1,8),PKW(pB1,10),PKW(pB1,12),PKW(pB1,14)};
    SBAR(); pv(o,vb0+sl_cur,PAF(0),PAF(1),PAF(2),PAF(3)); }
  #undef PKW
  #undef PAF
  #undef VFR
  #undef PIN
  #undef MX3
  #undef GAPA
  #undef GAPB
  #undef EX
  #undef VRD
  #undef KRD
  #undef STEP
  #undef ENDW
  {auto rr=__builtin_amdgcn_permlane32_swap(__float_as_uint(l_reg),__float_as_uint(l_reg),false,false);l_reg=__uint_as_float(rr[0])+__uint_as_float(rr[1]);}
  if(hi==0)wsf[32+r32]=l_reg;asm volatile("s_waitcnt lgkmcnt(0)":::"memory");
  float rli[16];
  #pragma unroll
  for(int r=0;r<16;++r)rli[r]=__builtin_amdgcn_rcpf(wsf[32+crow(r,hi)]);
  bf16*Ow=Ob+(long)(wid*QBLK)*opitch;
  { bf16*stg=(bf16*)(shm+LDS_OST)+wid*2048;
    #pragma unroll
    for(int r=0;r<16;++r){const int orow=crow(r,hi);
      #pragma unroll
      for(int d0=0;d0<2;++d0)stg[orow*64+d0*32+r32]=__float2bfloat16(o[d0][r]*rli[r]);}
    asm volatile("s_waitcnt lgkmcnt(0)":::"memory");
    #pragma unroll
    for(int i=0;i<4;++i){const int row=i*8+(lane>>3),ch=lane&7; const u32x4 v=*(const u32x4*)(stg+row*64+ch*8); ATTN_STORE16(Ow+(long)row*opitch+ch*8,v);} }
  asm volatile("s_waitcnt lgkmcnt(0)\n\ts_barrier":::"memory");
  #undef DMA_K
  #undef DMA_V
  #undef CMASK
  #undef START
  #undef RESC
  #undef ROT
}
constexpr int ATTN_LDS_BYTES=LDS_BYTES;
#undef SBAR
#undef WAIT_BAR
}
namespace cg = cooperative_groups;
#define LAS __attribute__((address_space(3)))
typedef unsigned short u16;
typedef unsigned v4u __attribute__((ext_vector_type(4)));
typedef unsigned v2u __attribute__((ext_vector_type(2)));
typedef float f32x4 __attribute__((ext_vector_type(4)));
#define LDS_WAIT() asm volatile("s_waitcnt lgkmcnt(0)" ::: "memory")
#define VM_WAIT() asm volatile("s_waitcnt vmcnt(0)" ::: "memory")
__device__ __forceinline__ unsigned f2bf(float f) { unsigned u = __builtin_bit_cast(unsigned, f); return (u + 0x7fffu + ((u >> 16) & 1u)) >> 16; }
__device__ __forceinline__ unsigned pk2(float lo, float hi) { return f2bf(lo) | (f2bf(hi) << 16); }
__device__ __forceinline__ float bflo(unsigned w) { return __uint_as_float(w << 16); }
__device__ __forceinline__ float bfhi(unsigned w) { return __uint_as_float(w & 0xffff0000u); }
__device__ __forceinline__ float wave_sum(float v) {
#pragma unroll
    for (int o = 1; o < 64; o <<= 1) v += __shfl_xor(v, o);
    return v;
}

constexpr int NWAVES = 8, NTHREADS = 512;
constexpr int DM = 1024, NB = 8, SEQ = 2048, CTXL = 256, MTOK = NB * SEQ, RPB = CTXL + SEQ  , MST = NB * RPB, INW = 2304, DFF = 2816, NMOD = 6 * DM;
constexpr int OFF_AQ = 0, OFF_AK = 512, OFF_AV = 1024, OFF_BQ = 1536, OFF_BK = 2048, OFF_BV = 2176;
constexpr float EPS = 1e-6f;
constexpr size_t MiB = 1u << 20;
constexpr size_t WS_MODS = 1 * MiB, WS_ZERO_BYTES = 2 * MiB;
constexpr size_t WS_ROPEC = 2 * MiB, WS_ROPES = WS_ROPEC + 4096, WS_CS128 = 2 * MiB + 65536;
constexpr size_t WS_WIN = 3 * MiB, WS_WO0 = 8 * MiB, WS_GU0 = 10 * MiB, WS_DN0 = 21 * MiB, WS_WO1 = 27 * MiB, WS_GU1 = 29 * MiB, WS_DN1 = 40 * MiB, WS_WCS = 46 * MiB;
constexpr size_t WS_HC = 62 * MiB, WS_BIG = 98 * MiB, WS_ATT = 186 * MiB, WS_TMP = 218 * MiB, WS_END = 250 * MiB;
constexpr int LDS_BYTES = 147456, LUT_OFF = 131072;
constexpr int NPHASE = 17;

struct Args { const float* in[27]; float* out; unsigned char* ws; int ph_lo, ph_hi; };

__device__ __forceinline__ void p0_transpose_item(const float* W, int K, int N, u16* WT, int mode, LAS float* scr, int item, int lane) {
    const int nblk = N / 32, kb = item / nblk, nb = item % nblk, k0 = 64 * kb, n0 = 32 * nb;
    int d0 = n0;
    if (mode == 1) { const int up = n0 >= DFF, j = up ? n0 - DFF : n0; d0 = (j >> 7) * 256 + up * 128 + (j & 127); }
#pragma unroll 8
    for (int i = 0; i < 32; ++i) { const int kk = 2 * i + (lane >> 5); scr[kk * 33 + (lane & 31)] = W[(size_t)(k0 + kk) * N + n0 + (lane & 31)]; }
    LDS_WAIT(); asm volatile("" ::: "memory");
    const int c = lane & 7;
#pragma unroll
    for (int j = 0; j < 4; ++j) { const int n = (lane >> 3) + 8 * j; const LAS float* s = scr + (8 * c) * 33 + n;
        v4u o; o.x = pk2(s[0 * 33], s[1 * 33]); o.y = pk2(s[2 * 33], s[3 * 33]); o.z = pk2(s[4 * 33], s[5 * 33]); o.w = pk2(s[6 * 33], s[7 * 33]);
        *(v4u*)(WT + (size_t)(d0 + n) * K + k0 + 8 * c) = o; }
    LDS_WAIT(); asm volatile("" ::: "memory");
}

__device__ __forceinline__ void norm_rows(const float* x, const float* ctx, bool stacked, u16* dst, const float* g, const float* mods, int shift_off, int scale_off, int gw, int NGW, int lane) {
    const int nrows = stacked ? MST : MTOK;
    for (int R = gw; R < nrows; R += NGW) {
        const float* src; const float* mrow;
        if (stacked) { const int b = R / RPB, r = R - b * RPB;
            if (r < CTXL) { src = ctx + (size_t)(b * CTXL + r) * DM; mrow = mods + 8 * NMOD; } else { src = x + (size_t)(b * SEQ + r - CTXL) * DM; mrow = mods + b * NMOD; } }
        else { src = x + (size_t)R * DM; mrow = mods + (R >> 11) * NMOD; }
        const f32x4* xr = (const f32x4*)src + lane;
        f32x4 v[4]; float s = 0.f;
#pragma unroll
        for (int j = 0; j < 4; ++j) { v[j] = xr[64 * j]; s += (v[j].x * v[j].x + v[j].y * v[j].y) + (v[j].z * v[j].z + v[j].w * v[j].w); }
        const float rstd = 1.0f / sqrtf(wave_sum(s) * (1.0f / DM) + EPS);
        unsigned long long* o8 = (unsigned long long*)(dst + (size_t)R * DM) + lane;
#pragma unroll
        for (int j = 0; j < 4; ++j) { const f32x4 gg = ((const f32x4*)g)[64 * j + lane], sc = ((const f32x4*)(mrow + scale_off))[64 * j + lane], sh = ((const f32x4*)(mrow + shift_off))[64 * j + lane];
            const f32x4 y = v[j] * rstd * gg * (sc + 1.0f) + sh;
            o8[64 * j] = (unsigned long long)pk2(y.x, y.y) | ((unsigned long long)pk2(y.z, y.w) << 32); }
    }
}

__global__ void __launch_bounds__(NTHREADS, 2) mega_fwd(Args args) {
    extern __shared__ __attribute__((aligned(16))) unsigned char lds[];
    LAS unsigned char* L = (LAS unsigned char*)lds;
    const int tid = threadIdx.x, lane = tid & 63, wave = __builtin_amdgcn_readfirstlane(tid >> 6);
    const int G = gridDim.x, bx = blockIdx.x;
    const int vcu = (G % 8 == 0) ? (bx % 8) * (G / 8) + bx / 8 : bx;
    const int gw = vcu * NWAVES + wave, NGW = G * NWAVES;
    unsigned char* ws = args.ws;
    const float* x_in = args.in[0]; float* out = args.out;
    float* mods = (float*)(ws + WS_MODS);
    u16* HC = (u16*)(ws + WS_HC); u16* BIG = (u16*)(ws + WS_BIG); u16* ATT = (u16*)(ws + WS_ATT); u16* TMP = (u16*)(ws + WS_TMP);
    const int lo = args.ph_lo, hi = args.ph_hi;
#ifndef PHMASK
#define PHMASK 0x1ffff
#endif
#define IN(k) (((PHMASK >> (k)) & 1) && lo <= (k) && (k) < hi)
#define SEAM(k) do { if (IN((k) + 1)) cg::this_grid().sync(); } while (0)

    if (IN(0)) {
        LAS float* lut = (LAS float*)(L + LUT_OFF);
        for (int m = tid; m < 2048; m += NTHREADS) lut[m] = cospif((float)m * (1.0f / 1024.0f));
        __syncthreads();
        for (int it = bx; it < 48; it += G) {
            const int l = it / 24, nc = it % 24; const float* W = args.in[l ? 19 : 4]; const float* bias = args.in[l ? 20 : 5];
            LAS float* sv = (LAS float*)(L + wave * 16384);
            const int k0 = wave * 128;
#pragma unroll
            for (int bb = 0; bb < 9; ++bb)
#pragma unroll
                for (int h = 0; h < 2; ++h) { const int k = k0 + h * 64 + lane; const float v = bb < 8 ? args.in[1][bb * DM + k] : args.in[3][k]; sv[bb * 128 + h * 64 + lane] = v / (1.0f + __expf(-v)); }
            LDS_WAIT(); asm volatile("" ::: "memory");
            f32x4 acc[9];
#pragma unroll
            for (int bb = 0; bb < 9; ++bb) acc[bb] = (f32x4){0.f, 0.f, 0.f, 0.f};
            const float* wp = W + (size_t)k0 * NMOD + nc * 256 + 4 * lane;
#pragma unroll 4
            for (int kk = 0; kk < 128; ++kk) { const f32x4 w = *(const f32x4*)(wp + (size_t)kk * NMOD);
#pragma unroll
                for (int bb = 0; bb < 9; ++bb) acc[bb] += w * sv[bb * 128 + kk]; }
            LDS_WAIT(); asm volatile("" ::: "memory");
            LAS f32x4* red = (LAS f32x4*)(L + wave * 16384);
#pragma unroll
            for (int bb = 0; bb < 9; ++bb) red[bb * 64 + lane] = acc[bb];
            __syncthreads();
            for (int o = tid; o < 9 * 64; o += NTHREADS) { f32x4 s = (f32x4){0.f, 0.f, 0.f, 0.f};
#pragma unroll
                for (int w8 = 0; w8 < 8; ++w8) s += ((LAS f32x4*)(L + w8 * 16384))[o];
                const int bb = o >> 6, ln = o & 63; s += *(const f32x4*)(bias + nc * 256 + 4 * ln);
                *(f32x4*)(mods + (size_t)(l * 9 + bb) * NMOD + nc * 256 + 4 * ln) = s; }
            __syncthreads();
        }
        {
            LAS float* scr = (LAS float*)(L + wave * 16384);
            constexpr int I_IN = 16 * 72, I_O = 16 * 32, I_GU = 16 * 176, I_DN = 44 * 32;
            constexpr int NIT = I_IN + 2 * (I_O + I_GU + I_DN);
            for (int it = gw; it < NIT; it += NGW) {
                int r = it;
                if (r < I_IN) { p0_transpose_item(args.in[7], DM, INW, (u16*)(ws + WS_WIN), 0, scr, r, lane); continue; } r -= I_IN;
                if (r < I_O) { p0_transpose_item(args.in[15], DM, DM, (u16*)(ws + WS_WO0), 0, scr, r, lane); continue; } r -= I_O;
                if (r < I_GU) { p0_transpose_item(args.in[17], DM, 2 * DFF, (u16*)(ws + WS_GU0), 1, scr, r, lane); continue; } r -= I_GU;
                if (r < I_DN) { p0_transpose_item(args.in[18], DFF, DM, (u16*)(ws + WS_DN0), 0, scr, r, lane); continue; } r -= I_DN;
                if (r < I_O) { p0_transpose_item(args.in[22], DM, DM, (u16*)(ws + WS_WO1), 0, scr, r, lane); continue; } r -= I_O;
                if (r < I_GU) { p0_transpose_item(args.in[24], DM, 2 * DFF, (u16*)(ws + WS_GU1), 1, scr, r, lane); continue; } r -= I_GU;
                p0_transpose_item(args.in[25], DFF, DM, (u16*)(ws + WS_DN1), 0, scr, r, lane);
            }
        }
        for (int k = gw; k < 2048; k += NGW) {
            u16* row = (u16*)(ws + WS_WCS) + (size_t)k * 4096;
#pragma unroll 2
            for (int i = 0; i < 8; ++i) { const int e0 = (i * 64 + lane) * 8, cs = e0 >> 11, n0 = e0 & 2047; float v[8];
#pragma unroll
                for (int e = 0; e < 8; ++e) { const int m = (k * (n0 + e)) & 2047; v[e] = cs ? -lut[(m - 512) & 2047] : lut[m]; }
                v4u o; o.x = pk2(v[0], v[1]); o.y = pk2(v[2], v[3]); o.z = pk2(v[4], v[5]); o.w = pk2(v[6], v[7]);
                *(v4u*)(row + e0) = o; }
        }
        for (int i = gw * 64 + lane; i < 256 * 128; i += NGW * 64) { const int r = i >> 7, j = i & 127, cs = r >> 7, jp = r & 127, m = ((jp * j) & 127) * 16;
            ((u16*)(ws + WS_CS128))[i] = (u16)f2bf(cs ? lut[(m - 512) & 2047] : lut[m]); }
        for (int i = gw * 64 + lane; i < 1024; i += NGW * 64) { const int pos = i >> 4, p = i & 15; const float inv = powf(10000.0f, -(float)p / 16.0f), ang = (float)pos * inv;
            ((float*)(ws + WS_ROPEC))[i] = cosf(ang); ((float*)(ws + WS_ROPES))[i] = sinf(ang); }
        SEAM(0);
    }
    if (IN(1)) { norm_rows(x_in, args.in[2], true, HC, args.in[6], mods, 0 * DM, 1 * DM, gw, NGW, lane); SEAM(1); }
    if (IN(2)) {
        pg8::GemmStd g{HC, (const u16*)(ws + WS_WIN), DM, DM, DM}; pg8::StaticOrder S; S.init(MST, INW, G, bx);
        pg8::EpiBf16 E{BIG, INW};
        pg8::gemm_phase<pg8::EpiBf16, pg8::GemmStd, pg8::StaticOrder, true, true>(L, g, S, E);
        SEAM(2);
    }
    if (IN(3)) {
        const float* ropeC = (const float*)(ws + WS_ROPEC); const float* ropeS = (const float*)(ws + WS_ROPES);
        const int sub = lane & 7, hs = lane >> 3, axis = sub >> 2, q4 = sub & 3, dcol = axis * 32 + 4 * q4;
        const f32x4 gq1 = *(const f32x4*)(args.in[13] + dcol), gq2 = *(const f32x4*)(args.in[13] + dcol + 16);
        const f32x4 gk1 = *(const f32x4*)(args.in[14] + dcol), gk2 = *(const f32x4*)(args.in[14] + dcol + 16);
        constexpr float C2 = 0.125f * 1.4426950408889634f;
        for (int R = gw; R < MST; R += NGW) {
            const int b = R / RPB, r = R - b * RPB; const bool isctx = r < CTXL; const int s = r - CTXL;
            const int pos = axis ? (s & 63) : (s >> 6);
            f32x4 cs = (f32x4){1.f, 1.f, 1.f, 1.f}, sn = (f32x4){0.f, 0.f, 0.f, 0.f};
            if (!isctx) { cs = *(const f32x4*)(ropeC + pos * 16 + 4 * q4); sn = *(const f32x4*)(ropeS + pos * 16 + 4 * q4); }
            u16* row = BIG + (size_t)R * INW;
#pragma unroll
            for (int it = 0; it < 4; ++it) {
                if (isctx && it != 3) continue;
                const bool act = (it != 3) || (hs < 2);
                const int col = (it == 0 ? OFF_AQ : it == 1 ? OFF_AK : it == 2 ? OFF_BQ : OFF_BK) + (act ? hs : 0) * 64 + dcol;
                const v2u w1 = *(const v2u*)(row + col), w2 = *(const v2u*)(row + col + 16);
                f32x4 x1 = (f32x4){bflo(w1.x), bfhi(w1.x), bflo(w1.y), bfhi(w1.y)}, x2 = (f32x4){bflo(w2.x), bfhi(w2.x), bflo(w2.y), bfhi(w2.y)};
                if (it >= 2) { float ss = (x1.x * x1.x + x1.y * x1.y) + (x1.z * x1.z + x1.w * x1.w) + (x2.x * x2.x + x2.y * x2.y) + (x2.z * x2.z + x2.w * x2.w);
                    ss += __shfl_xor(ss, 1); ss += __shfl_xor(ss, 2); ss += __shfl_xor(ss, 4);
                    const float rstd = 1.0f / sqrtf(ss * (1.0f / 64.0f) + EPS);
                    x1 = x1 * rstd * (it == 2 ? gq1 : gk1); x2 = x2 * rstd * (it == 2 ? gq2 : gk2); }
                f32x4 o1 = x1 * cs - x2 * sn, o2 = x2 * cs + x1 * sn;
                if (it == 0 || it == 2) { o1 = o1 * C2; o2 = o2 * C2; }
                if (act) { v2u a, c; a.x = pk2(o1.x, o1.y); a.y = pk2(o1.z, o1.w); c.x = pk2(o2.x, o2.y); c.y = pk2(o2.z, o2.w);
                    *(v2u*)(row + col) = a; *(v2u*)(row + col + 16) = c; }
            }
        }
        SEAM(3);
    }
    if (IN(4)) {
        typedef attn_body::bf16 abf;
        const abf* P = (const abf*)BIG;
        for (int s = vcu; s < 256; s += G) {
            const int b = s >> 5, i = s & 31;
            const abf* kvb = P + (size_t)b * RPB * INW;
            for (int r = 0; r < 6; ++r) {
                const abf *Qb, *Kh, *Vh; abf* Ob; int qb;
                if (r < 4) { const int h = i >> 3, m = r >> 1, v = r & 1; qb = i & 7;
                    Qb = kvb + (size_t)(CTXL + qb * 256) * INW + OFF_AQ + h * 128 + m * 64; Kh = kvb + OFF_AK + h * 128 + m * 64; Vh = kvb + OFF_AV + h * 128 + v * 64;
                    Ob = (abf*)TMP + (size_t)(b * SEQ + qb * 256) * DM + h * 256 + m * 128 + v * 64; }
                else { const int u = 2 * i + (r - 4), hq = u >> 3; qb = u & 7;
                    Qb = kvb + (size_t)(CTXL + qb * 256) * INW + OFF_BQ + hq * 64; Kh = kvb + OFF_BK + (hq >> 2) * 64; Vh = kvb + OFF_BV + (hq >> 2) * 64;
                    Ob = (abf*)ATT + (size_t)(b * SEQ + qb * 256) * DM + 512 + hq * 64; }
#ifndef SKIP_ATTN
                attn_body::attn_unit<8>(Qb, Kh, Vh, Ob, (char*)lds);
#endif
            }
        }
        asm volatile("" ::: "memory");
        for (int s = vcu; s < 256; s += G) {
            const int b = s >> 5, i = s & 31, qb = i & 7;
            {
                    VM_WAIT();
                    const float lam = expf(wave_sum(args.in[8][lane] * args.in[9][lane])) - expf(wave_sum(args.in[10][lane] * args.in[11][lane])) + 0.2f;
                    const int h = i >> 3, half = lane >> 5, l32 = lane & 31;
                    const f32x4 sg = *(const f32x4*)(args.in[12] + 4 * l32);
                    const size_t row0 = (size_t)(b * SEQ + qb * 256 + wave * 32);
                    for (int rr = 0; rr < 16; ++rr) { const size_t row = row0 + 2 * rr + half;
                        const unsigned long long* t1 = (const unsigned long long*)(TMP + row * DM + h * 256) + l32;
                        const unsigned long long a = __hip_atomic_load(t1, __ATOMIC_RELAXED, __HIP_MEMORY_SCOPE_AGENT), c = __hip_atomic_load(t1 + 32, __ATOMIC_RELAXED, __HIP_MEMORY_SCOPE_AGENT);
                        const unsigned a0 = (unsigned)a, a1 = (unsigned)(a >> 32), c0 = (unsigned)c, c1 = (unsigned)(c >> 32);
                        f32x4 d = (f32x4){bflo(a0) - lam * bflo(c0), bfhi(a0) - lam * bfhi(c0), bflo(a1) - lam * bflo(c1), bfhi(a1) - lam * bfhi(c1)};
                        float ss = (d.x * d.x + d.y * d.y) + (d.z * d.z + d.w * d.w);
                        ss += __shfl_xor(ss, 1); ss += __shfl_xor(ss, 2); ss += __shfl_xor(ss, 4); ss += __shfl_xor(ss, 8); ss += __shfl_xor(ss, 16);
                        const float rstd = 0.8f / sqrtf(ss * (1.0f / 128.0f) + EPS);
                        d = d * rstd * sg;
                        *(unsigned long long*)(ATT + row * DM + h * 128 + 4 * l32) = (unsigned long long)pk2(d.x, d.y) | ((unsigned long long)pk2(d.z, d.w) << 32); }
            }
        }
        SEAM(4);
    }
    if (IN(5)) {
        pg8::GemmStd g{ATT, (const u16*)(ws + WS_WO0), DM, DM, DM}; pg8::StaticOrder S; S.init(MTOK, DM, G, bx);
        pg8::EpiResGate E{x_in, out, mods + 2 * DM, NMOD};
        pg8::gemm_phase<pg8::EpiResGate, pg8::GemmStd, pg8::StaticOrder, true, true>(L, g, S, E);
        SEAM(5);
    }
    const float* ml0 = mods; const float* ml1 = mods + (size_t)9 * NMOD;
        if (IN(6)) { norm_rows(out, nullptr, false, HC, args.in[16], ml0, 3 * DM, 4 * DM, gw, NGW, lane); SEAM(6); }
        if (IN(7)) {
            pg8::GemmStd g{HC, (const u16*)(ws + (WS_GU0)), DM, DM, DM}; pg8::StaticOrder S; S.init(MTOK, 2 * DFF, G, bx);
            pg8::EpiSwiglu E{BIG, DFF};
            pg8::gemm_phase<pg8::EpiSwiglu, pg8::GemmStd, pg8::StaticOrder, true, true>(L, g, S, E);
            SEAM(7);
        }
        if (IN(8)) {
            pg8::GemmStd g{BIG, (const u16*)(ws + (WS_DN0)), DFF, DFF, DFF}; pg8::StaticOrder S; S.init(MTOK, DM, G, bx);
            pg8::EpiResGate E{out, out, ml0 + 5 * DM, NMOD};
            pg8::gemm_phase<pg8::EpiResGate, pg8::GemmStd, pg8::StaticOrder, true, true>(L, g, S, E);
            SEAM(8);
        }
            if (IN(9)) { norm_rows(out, nullptr, false, HC, args.in[21], ml1, 0 * DM, 1 * DM, gw, NGW, lane); SEAM(9); }
            if (IN(10)) {
                int k128 = 128; asm volatile("" : "+s"(k128));
                pg8::GemmF1 g{(const u16*)(ws + WS_CS128), HC, k128, 128, DM}; pg8::StaticOrder S; S.init(MTOK, 2048, G, bx);
                pg8::EpiF1 E{BIG};
                pg8::gemm_phase<pg8::EpiF1, pg8::GemmF1, pg8::StaticOrder, true, true>(L, g, S, E);
                SEAM(10);
            }
            if (IN(11)) {
                pg8::GemmF2 g{(const u16*)(ws + WS_WCS), BIG, 4096, 4096, 4096}; pg8::StaticOrder S; S.init(MTOK, DM, G, bx);
                pg8::EpiBf16 E{ATT, DM};
                pg8::gemm_phase<pg8::EpiBf16, pg8::GemmF2, pg8::StaticOrder, true, true>(L, g, S, E);
                SEAM(11);
            }
            if (IN(12)) {
                pg8::GemmStd g{ATT, (const u16*)(ws + WS_WO1), DM, DM, DM}; pg8::StaticOrder S; S.init(MTOK, DM, G, bx);
                pg8::EpiResGate E{out, out, ml1 + 2 * DM, NMOD};
                pg8::gemm_phase<pg8::EpiResGate, pg8::GemmStd, pg8::StaticOrder, true, true>(L, g, S, E);
                SEAM(12);
            }
        if (IN(13)) { norm_rows(out, nullptr, false, HC, args.in[23], ml1, 3 * DM, 4 * DM, gw, NGW, lane); SEAM(13); }
        if (IN(14)) {
            pg8::GemmStd g{HC, (const u16*)(ws + (WS_GU1)), DM, DM, DM}; pg8::StaticOrder S; S.init(MTOK, 2 * DFF, G, bx);
            pg8::EpiSwiglu E{BIG, DFF};
            pg8::gemm_phase<pg8::EpiSwiglu, pg8::GemmStd, pg8::StaticOrder, true, true>(L, g, S, E);
            SEAM(14);
        }
        if (IN(15)) {
            pg8::GemmStd g{BIG, (const u16*)(ws + (WS_DN1)), DFF, DFF, DFF}; pg8::StaticOrder S; S.init(MTOK, DM, G, bx);
            pg8::EpiResGate E{out, out, ml1 + 5 * DM, NMOD};
            pg8::gemm_phase<pg8::EpiResGate, pg8::GemmStd, pg8::StaticOrder, true, true>(L, g, S, E);
            SEAM(15);
        }
    if (IN(16)) {
        const float* g = args.in[26];
        for (int R = gw; R < MTOK; R += NGW) {
            f32x4* xr = (f32x4*)(out + (size_t)R * DM) + lane; f32x4 v[4]; float s = 0.f;
#pragma unroll
            for (int j = 0; j < 4; ++j) { v[j] = xr[64 * j]; s += (v[j].x * v[j].x + v[j].y * v[j].y) + (v[j].z * v[j].z + v[j].w * v[j].w); }
            const float rstd = 1.0f / sqrtf(wave_sum(s) * (1.0f / DM) + EPS);
#pragma unroll
            for (int j = 0; j < 4; ++j) xr[64 * j] = v[j] * rstd * ((const f32x4*)g)[64 * j + lane];
        }
    }
#undef IN
#undef SEAM
}

#ifndef MK_MULTI
#define MK_MULTI 0
#endif
extern "C" void kernel_launch(void* const* d_in, const int* in_sizes, int n_in, void* d_out, int out_size, void* d_ws, size_t ws_size, hipStream_t stream) {
    static int grid = 0;
    if (grid == 0) {
        if (n_in != 27 || out_size != MTOK * DM || ws_size < WS_END) { fprintf(stderr, "kernel_launch: unexpected shapes (n_in %d out %d ws %zu)\n", n_in, out_size, ws_size); grid = -1; return; }
        int dev = 0, cus = 0, per_cu = 0;
        hipGetDevice(&dev); hipDeviceGetAttribute(&cus, hipDeviceAttributeMultiprocessorCount, dev);
        hipFuncSetAttribute((const void*)mega_fwd, hipFuncAttributeMaxDynamicSharedMemorySize, LDS_BYTES);
        hipOccupancyMaxActiveBlocksPerMultiprocessor(&per_cu, (const void*)mega_fwd, NTHREADS, LDS_BYTES);
        if (per_cu < 1) { fprintf(stderr, "kernel_launch: occupancy query says %d blocks/CU\n", per_cu); per_cu = 1; }
        grid = cus * 1;
        (void)hipGetLastError();
    }
    if (grid < 0) return;
    Args a{};
    for (int i = 0; i < 27; ++i) a.in[i] = (const float*)d_in[i];
    a.out = (float*)d_out; a.ws = (unsigned char*)d_ws;
#if MK_MULTI
    for (int p = 0; p < NPHASE; ++p) { a.ph_lo = p; a.ph_hi = p + 1; hipLaunchKernelGGL(mega_fwd, dim3(grid), dim3(NTHREADS), LDS_BYTES, stream, a); }
#else
    a.ph_lo = 0; a.ph_hi = NPHASE;
    void* kargs[] = {&a};
    hipError_t e = hipLaunchCooperativeKernel((const void*)mega_fwd, dim3(grid), dim3(NTHREADS), kargs, LDS_BYTES, stream);
    if (e != hipSuccess) fprintf(stderr, "cooperative launch failed: %s (grid %d)\n", hipGetErrorString(e), grid);
#endif
}
```

```cpp
#include <hip/hip_runtime.h>
#include <hip/hip_cooperative_groups.h>
#include <hip/hip_bf16.h>
#include <cstdio>
#include <cstdint>
#include <cmath>
namespace pg8 {
#define PG8_LAS __attribute__((address_space(3)))
typedef unsigned short bf16_t;
typedef short bf16x8 __attribute__((ext_vector_type(8)));
typedef float f32x4 __attribute__((ext_vector_type(4)));
typedef unsigned u32x4 __attribute__((ext_vector_type(4)));
constexpr int BM = 256, BK = 64, HALF = 128, HTB = HALF * BK * 2  , STAGE_BYTES = 8 * HTB, NXCD = 8, WGM = 8;

__host__ __device__ __forceinline__ int lds_byte(int r, int c) { const int st = (r >> 4) * 2 + (c >> 5), rr = r & 15, cc = c & 31, ob = rr * 64 + cc * 2; return st * 1024 + (ob ^ (((ob >> 9) & 1) << 5)); }
__host__ __device__ __forceinline__ void stage_rc(int b, int& R, int& C) { const int st = b / 1024, sb = b % 1024, swz = sb ^ (((sb >> 9) & 1) << 5); R = (st >> 1) * 16 + swz / 64; C = (st & 1) * 32 + (swz % 64) / 2; }
__host__ __device__ __forceinline__ int perm32(int rho) { const int n = rho >> 4, i = rho & 15; return 8 * (i >> 2) + 4 * n + (i & 3); }
struct Unit { int pm, pn; };
struct Gemm { const bf16_t* A; const bf16_t* Bt; int M, N, K; };

struct StaticOrder {
    int nM, nN, nwg, G, c;
    __host__ __device__ void init(int M, int N, int G_, int c_) { nM = M / BM; nN = N / BM; nwg = nM * nN; G = G_; c = c_; }
    __host__ __device__ bool next(int i, Unit& u) const {
        const long L = (long)i * G + c; if (L >= nwg) return false;
        int wgid = (int)L; { const int q = nwg / NXCD, r = nwg % NXCD, xcd = wgid % NXCD, off = wgid / NXCD; wgid = (xcd < r ? xcd * (q + 1) : r * (q + 1) + (xcd - r) * q) + off; }
        const int nig = WGM * nN, gid = wgid / nig, fm = gid * WGM, gsz = (nM - fm) < WGM ? (nM - fm) : WGM;
        u.pm = fm + ((wgid % nig) % gsz); u.pn = (wgid % nig) / gsz; return true;
    }
    __device__ __forceinline__ void a_ready(const Unit&) const {}
    __device__ __forceinline__ void done(const Unit&) const {}
};
__device__ __forceinline__ unsigned cvt_pk_bf16(float lo, float hi) { unsigned r; asm volatile("v_cvt_pk_bf16_f32 %0, %1, %2" : "=v"(r) : "v"(lo), "v"(hi)); return r; }
typedef float f32x2 __attribute__((ext_vector_type(2)));
struct GemmStd { const bf16_t* A; const bf16_t* Bt; int K, lda, ldb;
    __device__ __forceinline__ const char* aptr(const Unit& u) const { return (const char*)A + (size_t)u.pm * BM * lda * 2; }
    __device__ __forceinline__ const char* bptr(const Unit& u) const { return (const char*)Bt + (size_t)u.pn * BM * ldb * 2; } };
struct GemmF1 { const bf16_t* A; const bf16_t* Bt; int K, lda, ldb;
    __device__ __forceinline__ const char* aptr(const Unit&) const { return (const char*)A; }
    __device__ __forceinline__ const char* bptr(const Unit& u) const { return (const char*)Bt + ((size_t)((u.pm >> 3) * 2048 + u.pn * 256) * 1024 + (size_t)(u.pm & 7) * 128) * 2; } };
struct GemmF2 { const bf16_t* A; const bf16_t* Bt; int K, lda, ldb;
    __device__ __forceinline__ const char* aptr(const Unit& u) const { return (const char*)A + (size_t)(u.pm & 7) * 256 * 4096 * 2; }
    __device__ __forceinline__ const char* bptr(const Unit& u) const { return (const char*)Bt + ((size_t)(u.pm >> 3) * 1024 + (size_t)u.pn * 256) * 4096 * 2; } };

struct EpiBf16 {
    static constexpr bool PERM = true, AFTER_DRAIN = false;
    bf16_t* O; int ldc;
    __device__ __forceinline__ void operator()(const f32x4 (&acc)[2][2][4][2], const Unit& u, int wr, int wc, int fr, int fq) const {
        const int row0 = u.pm * BM + wr * 64 + fr, col0 = u.pn * BM + wc * 32 + 8 * fq;
#pragma unroll
        for (int ai = 0; ai < 2; ++ai)
#pragma unroll
            for (int m = 0; m < 4; ++m) { bf16_t* rowp = O + (size_t)(row0 + ai * HALF + m * 16) * ldc + col0;
#pragma unroll
                for (int bj = 0; bj < 2; ++bj) { const f32x4 v0 = acc[ai][bj][m][0], v1 = acc[ai][bj][m][1];
                    u32x4 w; w.x = cvt_pk_bf16(v0[0], v0[1]); w.y = cvt_pk_bf16(v0[2], v0[3]); w.z = cvt_pk_bf16(v1[0], v1[1]); w.w = cvt_pk_bf16(v1[2], v1[3]);
                    *(u32x4*)(rowp + bj * HALF) = w; } }
    }
};
struct EpiF1 {
    static constexpr bool PERM = true, AFTER_DRAIN = false;
    bf16_t* YT;
    __device__ __forceinline__ void operator()(const f32x4 (&acc)[2][2][4][2], const Unit& u, int wr, int wc, int fr, int fq) const {
        const int b = u.pm >> 3, g = u.pm & 7; const float sc = 1.0f / 512.0f;
        const int col0 = u.pn * BM + wc * 32 + 8 * fq;
#pragma unroll
        for (int ai = 0; ai < 2; ++ai)
#pragma unroll
            for (int m = 0; m < 4; ++m) { bf16_t* rowp = YT + ((size_t)(b * 1024 + g * 128 + wr * 64 + m * 16 + fr)) * 4096 + ai * 2048 + col0;
#pragma unroll
                for (int bj = 0; bj < 2; ++bj) { const f32x4 v0 = acc[ai][bj][m][0] * sc, v1 = acc[ai][bj][m][1] * sc;
                    u32x4 w; w.x = cvt_pk_bf16(v0[0], v0[1]); w.y = cvt_pk_bf16(v0[2], v0[3]); w.z = cvt_pk_bf16(v1[0], v1[1]); w.w = cvt_pk_bf16(v1[2], v1[3]);
                    *(u32x4*)(rowp + bj * HALF) = w; }
                asm volatile("" ::: "memory"); }
    }
};
__device__ __forceinline__ float silu_mul(float g, float u) { return g * u * __builtin_amdgcn_rcpf(1.0f + __builtin_amdgcn_exp2f(-1.4426950408889634f * g)); }
struct EpiSwiglu {
    static constexpr bool PERM = true, AFTER_DRAIN = false;
    bf16_t* O; int ldc;
    __device__ __forceinline__ void operator()(const f32x4 (&acc)[2][2][4][2], const Unit& u, int wr, int wc, int fr, int fq) const {
        const int row0 = u.pm * BM + wr * 64 + fr, col0 = u.pn * HALF + wc * 32 + 8 * fq;
#pragma unroll
        for (int ai = 0; ai < 2; ++ai)
#pragma unroll
            for (int m = 0; m < 4; ++m) { bf16_t* rowp = O + (size_t)(row0 + ai * HALF + m * 16) * ldc + col0;
                const f32x4 g0 = acc[ai][0][m][0], g1 = acc[ai][0][m][1], u0 = acc[ai][1][m][0], u1 = acc[ai][1][m][1];
                u32x4 w; w.x = cvt_pk_bf16(silu_mul(g0[0], u0[0]), silu_mul(g0[1], u0[1])); w.y = cvt_pk_bf16(silu_mul(g0[2], u0[2]), silu_mul(g0[3], u0[3]));
                w.z = cvt_pk_bf16(silu_mul(g1[0], u1[0]), silu_mul(g1[1], u1[1])); w.w = cvt_pk_bf16(silu_mul(g1[2], u1[2]), silu_mul(g1[3], u1[3]));
                *(u32x4*)rowp = w; }
    }
};
struct EpiResGate {
    static constexpr bool PERM = false, AFTER_DRAIN = false;
    const float* base; float* out; const float* gate; int gstride;
    __device__ __forceinline__ void operator()(const f32x4 (&acc)[2][2][4][2], const Unit& u, int wr, int wc, int fr, int fq) const {
        const int col0 = u.pn * BM + wc * 32 + 4 * fq; const float* gp = gate + (size_t)(u.pm >> 3) * gstride + col0;
        f32x4 gv[2][2];
#pragma unroll
        for (int bj = 0; bj < 2; ++bj)
#pragma unroll
            for (int n = 0; n < 2; ++n) gv[bj][n] = *(const f32x4*)(gp + bj * HALF + n * 16);
#pragma unroll
        for (int ai = 0; ai < 2; ++ai)
#pragma unroll
            for (int m = 0; m < 4; ++m) { const size_t off = (size_t)(u.pm * BM + ai * HALF + wr * 64 + m * 16 + fr) * 1024 + col0;
#pragma unroll
                for (int bj = 0; bj < 2; ++bj)
#pragma unroll
                    for (int n = 0; n < 2; ++n) { const f32x4 bs = *(const f32x4*)(base + off + bj * HALF + n * 16); *(f32x4*)(out + off + bj * HALF + n * 16) = bs + gv[bj][n] * acc[ai][bj][m][n]; }
                if (m & 1) asm volatile("" ::: "memory"); }
    }
};
template <class Epi, class G, class Sched, bool ALIGN_EPI = false, bool SP2 = false>
__device__ __forceinline__ void gemm_phase(PG8_LAS unsigned char* lds, const G g, const Sched& S, const Epi& E) {
    const int tid = threadIdx.x, wid = __builtin_amdgcn_readfirstlane(tid >> 6), lane = tid & 63, wr = wid >> 2, wc = wid & 3, fr = lane & 15, fq = lane >> 4;
    const int K = g.K, nt = K / BK;
    unsigned voffA[2], voffB[2];
#pragma unroll
    for (int i = 0; i < 2; ++i) { int R, C; stage_rc(tid * 16 + i * 8192, R, C); const int Rb = Epi::PERM ? ((R & ~31) + perm32(R & 31)) : R;
        voffA[i] = (unsigned)(R * g.lda + C) * 2u; voffB[i] = (unsigned)(Rb * g.ldb + C) * 2u; }
    const size_t kstep = (size_t)(BK * 2);
    const size_t hstepA = (size_t)HALF * g.lda * 2, hstepB = (size_t)HALF * g.ldb * 2;
    const unsigned ldsw = (unsigned)wid * 1024u;
    const int aoff = lds_byte(wr * 64 + fr, fq * 8), boff = lds_byte(wc * 32 + fr, fq * 8);
#define PG8_SA(b, h) (((b) * 2 + (h)) * HTB)
#define PG8_SB(b, h) ((4 + (b) * 2 + (h)) * HTB)
#define PG8_STAGE(bufoff, gbase, voff) do { _Pragma("unroll") for (int _i = 0; _i < 2; ++_i) \
        __builtin_amdgcn_global_load_lds((const unsigned*)((const char*)(gbase) + (voff)[_i]), (PG8_LAS unsigned*)(lds + (bufoff) + ldsw + _i * 8192), 16, 0, 0); } while (0)
#define PG8_LDA(dst, b, h) do { _Pragma("unroll") for (int m = 0; m < 4; ++m) _Pragma("unroll") for (int k = 0; k < 2; ++k) dst[m][k] = *(const PG8_LAS bf16x8*)(lds + PG8_SA(b, h) + aoff + m * 2048 + k * 1024); } while (0)
#define PG8_LDB(dst, b, h) do { _Pragma("unroll") for (int n = 0; n < 2; ++n) _Pragma("unroll") for (int k = 0; k < 2; ++k) dst[n][k] = *(const PG8_LAS bf16x8*)(lds + PG8_SB(b, h) + boff + n * 2048 + k * 1024); } while (0)
#define PG8_MMA(ai, bj, At, Bt) do { __builtin_amdgcn_s_setprio(1); _Pragma("unroll") for (int m = 0; m < 4; ++m) _Pragma("unroll") for (int n = 0; n < 2; ++n) _Pragma("unroll") for (int k = 0; k < 2; ++k) \
        acc[ai][bj][m][n] = __builtin_amdgcn_mfma_f32_16x16x32_bf16(Bt[n][k], At[m][k], acc[ai][bj][m][n], 0, 0, 0); __builtin_amdgcn_s_setprio(0); } while (0)
#define PG8_WAIT_V(n) asm volatile("s_waitcnt vmcnt(" #n ")" ::: "memory")
#define PG8_WAIT_L(n) asm volatile("s_waitcnt lgkmcnt(" #n ")" ::: "memory")
#define PG8_BAR __builtin_amdgcn_s_barrier()
#define PG8_SCHED __builtin_amdgcn_sched_barrier(0)
    Unit cur, nxt; int ui = 0;
    if (!S.next(0, cur)) return;
    f32x4 acc[2][2][4][2];
#pragma unroll
    for (int a = 0; a < 2; ++a)
#pragma unroll
        for (int b = 0; b < 2; ++b)
#pragma unroll
            for (int m = 0; m < 4; ++m)
#pragma unroll
                for (int n = 0; n < 2; ++n) acc[a][b][m][n] = (f32x4){0.f, 0.f, 0.f, 0.f};
    bf16x8 At[4][2], B0[2][2], B1[2][2];
    const char* cA = g.aptr(cur); const char* cB = g.bptr(cur);
    S.a_ready(cur);
    if constexpr (SP2) {
        PG8_STAGE(PG8_SB(0, 0), cB, voffB); PG8_STAGE(PG8_SB(0, 1), cB + hstepB, voffB); PG8_STAGE(PG8_SA(0, 0), cA, voffA); PG8_STAGE(PG8_SA(0, 1), cA + hstepA, voffA);
        if (wr == 1) PG8_BAR;
        PG8_WAIT_V(2); PG8_BAR;
        PG8_STAGE(PG8_SB(1, 0), cB + kstep, voffB); PG8_STAGE(PG8_SA(1, 0), cA + kstep, voffA); PG8_STAGE(PG8_SB(1, 1), cB + hstepB + kstep, voffB);
        PG8_WAIT_V(6); PG8_BAR;
    } else {
        PG8_STAGE(PG8_SB(0, 0), cB, voffB); PG8_STAGE(PG8_SA(0, 0), cA, voffA); PG8_STAGE(PG8_SB(0, 1), cB + hstepB, voffB); PG8_STAGE(PG8_SA(0, 1), cA + hstepA, voffA);
        if (wr == 1) PG8_BAR;
        PG8_WAIT_V(4); PG8_BAR;
        PG8_STAGE(PG8_SB(1, 0), cB + kstep, voffB); PG8_STAGE(PG8_SA(1, 0), cA + kstep, voffA); PG8_STAGE(PG8_SB(1, 1), cB + hstepB + kstep, voffB);
        PG8_WAIT_V(6); PG8_BAR;
    }
    for (;;) {
        const bool has_next = S.next(ui + 1, nxt);
        const char* nA = has_next ? g.aptr(nxt) : cA; const char* nB = has_next ? g.bptr(nxt) : cB;
        for (int t = 0; t < nt; t += 2) {
            const bool last = (t == nt - 2);
            const char* a1 = cA + (size_t)(t + 1) * kstep;
            const char* a2 = last ? nA : cA + (size_t)(t + 2) * kstep; const char* b2 = last ? nB : cB + (size_t)(t + 2) * kstep;
            const char* a3 = a2 + kstep; const char* b3 = b2 + kstep;
            if (last && has_next) S.a_ready(nxt);
            if constexpr (SP2) {
            PG8_LDB(B0, 0, 0); PG8_LDB(B1, 0, 1); PG8_SCHED; PG8_LDA(At, 0, 0); PG8_STAGE(PG8_SA(1, 1), a1 + hstepA, voffA);
            PG8_WAIT_V(8); PG8_WAIT_L(0); PG8_BAR; PG8_MMA(0, 0, At, B0); PG8_MMA(0, 1, At, B1); PG8_BAR; PG8_SCHED;
            PG8_LDA(At, 0, 1); PG8_STAGE(PG8_SB(0, 0), b2, voffB); PG8_STAGE(PG8_SB(0, 1), b2 + hstepB, voffB); PG8_STAGE(PG8_SA(0, 0), a2, voffA);
            PG8_WAIT_V(8); PG8_WAIT_L(0); PG8_BAR; PG8_MMA(1, 0, At, B0); PG8_MMA(1, 1, At, B1); PG8_BAR; PG8_SCHED;
            PG8_LDB(B0, 1, 0); PG8_LDB(B1, 1, 1); PG8_SCHED; PG8_LDA(At, 1, 0); PG8_STAGE(PG8_SA(0, 1), a2 + hstepA, voffA);
            PG8_WAIT_V(8); PG8_WAIT_L(0); PG8_BAR; PG8_MMA(0, 0, At, B0); PG8_MMA(0, 1, At, B1); PG8_BAR; PG8_SCHED;
            PG8_LDA(At, 1, 1); PG8_STAGE(PG8_SB(1, 0), b3, voffB); PG8_STAGE(PG8_SB(1, 1), b3 + hstepB, voffB); PG8_STAGE(PG8_SA(1, 0), a3, voffA);
            PG8_WAIT_V(8); PG8_WAIT_L(0); PG8_BAR; PG8_MMA(1, 0, At, B0); PG8_MMA(1, 1, At, B1); PG8_BAR; PG8_SCHED;
            } else {
            PG8_LDB(B0, 0, 0); PG8_SCHED; PG8_LDA(At, 0, 0); PG8_STAGE(PG8_SA(1, 1), a1 + hstepA, voffA);
            PG8_WAIT_L(8); PG8_BAR; PG8_WAIT_L(0); PG8_MMA(0, 0, At, B0); PG8_BAR; PG8_SCHED;
            PG8_LDB(B1, 0, 1); PG8_STAGE(PG8_SB(0, 0), b2, voffB);
            PG8_BAR; PG8_WAIT_L(0); PG8_MMA(0, 1, At, B1); PG8_BAR;
            PG8_LDA(At, 0, 1); PG8_STAGE(PG8_SA(0, 0), a2, voffA);
            PG8_BAR; PG8_WAIT_L(0); PG8_MMA(1, 0, At, B0); PG8_BAR; PG8_SCHED;
            PG8_STAGE(PG8_SB(0, 1), b2 + hstepB, voffB);
            PG8_WAIT_V(6); PG8_BAR; PG8_MMA(1, 1, At, B1); PG8_BAR;
            PG8_LDB(B0, 1, 0); PG8_SCHED; PG8_LDA(At, 1, 0); PG8_STAGE(PG8_SA(0, 1), a2 + hstepA, voffA);
            PG8_WAIT_L(8); PG8_BAR; PG8_WAIT_L(0); PG8_MMA(0, 0, At, B0); PG8_BAR; PG8_SCHED;
            PG8_LDB(B1, 1, 1); PG8_STAGE(PG8_SB(1, 0), b3, voffB);
            PG8_BAR; PG8_WAIT_L(0); PG8_MMA(0, 1, At, B1); PG8_BAR;
            PG8_LDA(At, 1, 1); PG8_STAGE(PG8_SA(1, 0), a3, voffA);
            PG8_BAR; PG8_WAIT_L(0); PG8_MMA(1, 0, At, B0); PG8_BAR; PG8_SCHED;
            PG8_STAGE(PG8_SB(1, 1), b3 + hstepB, voffB);
            PG8_WAIT_V(6); PG8_BAR; PG8_MMA(1, 1, At, B1); PG8_BAR;
            }
        }
        if constexpr (ALIGN_EPI) { if (wr == 0) PG8_BAR; }
        if constexpr (!Epi::AFTER_DRAIN) { E(acc, cur, wr, wc, fr, fq); S.done(cur); }
        if (!has_next) break;
#pragma unroll
        for (int a = 0; a < 2; ++a)
#pragma unroll
            for (int b = 0; b < 2; ++b)
#pragma unroll
                for (int m = 0; m < 4; ++m)
#pragma unroll
                    for (int n = 0; n < 2; ++n) acc[a][b][m][n] = (f32x4){0.f, 0.f, 0.f, 0.f};
        cur = nxt; cA = nA; cB = nB; ++ui;
        if constexpr (ALIGN_EPI) { if (wr == 1) PG8_BAR; }
    }
    PG8_WAIT_V(0);
    if constexpr (!ALIGN_EPI) { if (wr == 0) PG8_BAR; }
    PG8_BAR;
    if constexpr (Epi::AFTER_DRAIN) { E.fused(acc, cur, wr, wc, fr, fq, lds, wid, lane); S.done(cur); }
#undef PG8_SA
#undef PG8_SB
#undef PG8_STAGE
#undef PG8_LDA
#undef PG8_LDB
#undef PG8_MMA
#undef PG8_WAIT_V
#undef PG8_WAIT_L
#undef PG8_BAR
#undef PG8_SCHED
}
}
namespace attn_body {
using bf16=__hip_bfloat16;
using bf16x8=__attribute__((ext_vector_type(8)))short;
using s16x4=__attribute__((ext_vector_type(4)))short;
using f32x16=__attribute__((ext_vector_type(16)))float;
using u32x4=__attribute__((ext_vector_type(4)))unsigned;
constexpr int D=64,DM=2304,NKEYS=2304;
constexpr int NW=8,QBLK=32,QB=QBLK*NW,KVBLK=64;
__device__ __forceinline__ int crow(int r,int hi){return (r&3)+8*(r>>2)+4*hi;}
#define SBAR() __builtin_amdgcn_sched_barrier(0)
__device__ __forceinline__ void cmask(f32x16&p0,f32x16&p1,int jb,int qrel,int hi){
  const float NEG=-INFINITY; int kb=64*jb+4*hi;
  #pragma unroll
  for(int r=0;r<16;++r){int kv=kb+(r&3)+8*(r>>2); if(kv>qrel)p0[r]=NEG; if(kv+32>qrel)p1[r]=NEG;}
}

constexpr int NSLOT=3, SLOTB=8192;
constexpr int LDS_K=0, LDS_V=NSLOT*SLOTB, LDS_WS=2*NSLOT*SLOTB, LDS_OST=LDS_WS+NW*64*4, LDS_BYTES=LDS_OST+NW*4096;
constexpr float C2=0.125f*1.4426950408889634f;
__device__ __forceinline__ void glds16(const void*gsrc,unsigned lds_dst){unsigned keep;
  asm volatile("s_mov_b32 %0, m0\n\ts_mov_b32 m0, %2\n\ts_nop 0\n\tglobal_load_lds_dwordx4 %1, off\n\ts_mov_b32 m0, %0":"=&s"(keep):"v"(gsrc),"s"(lds_dst):"memory");}
__device__ __forceinline__ float max3f(float a,float b,float c){float r;asm("v_max3_f32 %0, %1, %2, %3":"=v"(r):"v"(a),"v"(b),"v"(c));return r;}
__device__ __forceinline__ float max2f(float a,float b){float r;asm("v_max_f32_e32 %0, %1, %2":"=v"(r):"v"(a),"v"(b));return r;}
__device__ __forceinline__ float fadd_s(float a,float b){float r;asm("v_add_f32_e32 %0, %1, %2":"=v"(r):"v"(a),"v"(b));return r;}
__device__ __forceinline__ float fsub_s(float a,float b){float r;asm("v_sub_f32_e32 %0, %1, %2":"=v"(r):"v"(a),"v"(b));return r;}
typedef float f32x2_t __attribute__((ext_vector_type(2))); typedef __bf16 bf16x2_t __attribute__((ext_vector_type(2)));
__device__ __forceinline__ unsigned cvtpk_s(float lo,float hi){f32x2_t v={lo,hi};bf16x2_t b=__builtin_convertvector(v,bf16x2_t);return __builtin_bit_cast(unsigned,b);}
#define WAIT_BAR(N) asm volatile("s_waitcnt vmcnt(" #N ") lgkmcnt(0)\n\ts_barrier":::"memory")

__device__ __forceinline__ void qkt(f32x16&p0,f32x16&p1,const char*Kslot,const bf16x8*qr,const f32x16&negm,int r32,int hi){
  const char*kb=Kslot+hi*1024+r32*16;
  #pragma unroll
  for(int d0=0;d0<4;++d0){
    const bf16x8 b0=*reinterpret_cast<const bf16x8*>(kb+d0*2048);
    const bf16x8 b1=*reinterpret_cast<const bf16x8*>(kb+d0*2048+512);
    if(d0==0){p0=__builtin_amdgcn_mfma_f32_32x32x16_bf16(b0,qr[0],negm,0,0,0);p1=__builtin_amdgcn_mfma_f32_32x32x16_bf16(b1,qr[0],negm,0,0,0);}
    else{p0=__builtin_amdgcn_mfma_f32_32x32x16_bf16(b0,qr[d0],p0,0,0,0);p1=__builtin_amdgcn_mfma_f32_32x32x16_bf16(b1,qr[d0],p1,0,0,0);}}
}
typedef __attribute__((address_space(3))) const char* lds_cptr;
typedef short v4i16_t __attribute__((ext_vector_type(4)));
__device__ __forceinline__ void kload8(bf16x8*kf,lds_cptr kp){
  kf[0]=*(const __attribute__((address_space(3))) bf16x8*)(kp);      kf[1]=*(const __attribute__((address_space(3))) bf16x8*)(kp+512);
  kf[2]=*(const __attribute__((address_space(3))) bf16x8*)(kp+2048); kf[3]=*(const __attribute__((address_space(3))) bf16x8*)(kp+2560);
  kf[4]=*(const __attribute__((address_space(3))) bf16x8*)(kp+4096); kf[5]=*(const __attribute__((address_space(3))) bf16x8*)(kp+4608);
  kf[6]=*(const __attribute__((address_space(3))) bf16x8*)(kp+6144); kf[7]=*(const __attribute__((address_space(3))) bf16x8*)(kp+6656);
}
__device__ __forceinline__ void kload2(bf16x8*kf,lds_cptr kp,int j){ kf[2*j]=*(const __attribute__((address_space(3))) bf16x8*)(kp+j*2048); kf[2*j+1]=*(const __attribute__((address_space(3))) bf16x8*)(kp+j*2048+512); }
__device__ __forceinline__ s16x4 vtr(lds_cptr p){ return __builtin_bit_cast(s16x4,__builtin_amdgcn_ds_read_tr16_b64_v4i16((__attribute__((address_space(3))) v4i16_t*)p)); }
__device__ __forceinline__ float rowmax(const f32x16&p0,const f32x16&p1){
  float a=max3f(p0[0],p0[1],p1[0]),b=max3f(p0[2],p0[3],p1[1]);a=max3f(a,p1[2],p1[3]);
  #pragma unroll
  for(int r=4;r<16;r+=4){a=max3f(a,p0[r],p0[r+1]);b=max3f(b,p0[r+2],p0[r+3]);a=max3f(a,p1[r],p1[r+1]);b=max3f(b,p1[r+2],p1[r+3]);}
  const float m=max2f(a,b);
  auto rr=__builtin_amdgcn_permlane32_swap(__float_as_uint(m),__float_as_uint(m),false,false);
  return max2f(__uint_as_float(rr[0]),__uint_as_float(rr[1]));
}
__device__ __forceinline__ void pv(f32x16*o,int vb,bf16x8 pa0,bf16x8 pa1,bf16x8 pa2,bf16x8 pa3){
  #pragma unroll
  for(int d0=0;d0<2;++d0){s16x4 lo[4],hi[4];
    #pragma unroll
    for(int ks=0;ks<4;++ks){
      asm volatile("ds_read_b64_tr_b16 %0,%1 offset:%c2":"=&v"(lo[ks]):"v"(vb),"i"(d0*4096+ks*1024):"memory");
      asm volatile("ds_read_b64_tr_b16 %0,%1 offset:%c2":"=&v"(hi[ks]):"v"(vb),"i"(d0*4096+ks*1024+512):"memory");}
    asm volatile("s_waitcnt lgkmcnt(0)":::"memory");SBAR();
    #define PK(k) (bf16x8){lo[k][0],lo[k][1],lo[k][2],lo[k][3],hi[k][0],hi[k][1],hi[k][2],hi[k][3]}
    o[d0]=__builtin_amdgcn_mfma_f32_32x32x16_bf16(pa0,PK(0),o[d0],0,0,0);
    o[d0]=__builtin_amdgcn_mfma_f32_32x32x16_bf16(pa1,PK(1),o[d0],0,0,0);
    o[d0]=__builtin_amdgcn_mfma_f32_32x32x16_bf16(pa2,PK(2),o[d0],0,0,0);
    o[d0]=__builtin_amdgcn_mfma_f32_32x32x16_bf16(pa3,PK(3),o[d0],0,0,0);
    #undef PK
  }
}

#ifndef ATTN_STORE16
#define ATTN_STORE16(p,v) (*(u32x4*)(p)=(v))
#endif
template<int THRL> __device__ __forceinline__ void attn_unit(const bf16*Qb,const bf16*__restrict__ Kh,const bf16*__restrict__ Vh,bf16*Ob,char*shm){
  constexpr int opitch=1024;
  const int tid=threadIdx.x,lane=tid&63,r32=lane&31,hi=lane>>5; const int wid=__builtin_amdgcn_readfirstlane(tid>>6);
  const bf16*Qw=Qb+(long)(wid*QBLK)*DM;
  const unsigned lds0=(unsigned)(uintptr_t)shm;
  float*wsf=(float*)(shm+LDS_WS)+wid*64;
  const bf16*ksrc=Kh+(long)lane*DM+wid*8;
  const bf16*vsrc=Vh+(long)(16*(wid&3)+(lane>>2))*DM+(wid>>2)*32+(lane&3)*8;
  const unsigned kdst=lds0+LDS_K+wid*1024, vdst=lds0+LDS_V+wid*1024;
  #define DMA_K(t,slot) glds16(ksrc+(long)(t)*KVBLK*DM,(unsigned)__builtin_amdgcn_readfirstlane(kdst+(slot)))
  #define DMA_V(t,slot) glds16(vsrc+(long)(t)*KVBLK*DM,(unsigned)__builtin_amdgcn_readfirstlane(vdst+(slot)))
  const int vb0=(int)(lds0+LDS_V)+((lane>>4)&1)*32+(lane&3)*8+(4*hi+((lane&15)>>2))*64;
  const char*Kbase=shm+LDS_K; bf16x8 kf[8];
  const lds_cptr shm3=(lds_cptr)shm; const lds_cptr kp0=shm3+LDS_K+hi*1024+r32*16; const lds_cptr vp0=shm3+LDS_V+((lane>>4)&1)*32+(lane&3)*8+(4*hi+((lane&15)>>2))*64;
  const int NT=NKEYS/KVBLK;
  DMA_K(0,0);DMA_V(0,0);DMA_K(1,SLOTB);
  bf16x8 qr[4];
  #pragma unroll
  for(int d0=0;d0<4;++d0)qr[d0]=*reinterpret_cast<const bf16x8*>(&Qw[(long)r32*DM+d0*16+hi*8]);
  float mhat=0.f,l_reg=0.f;f32x16 o[2];o[0]=f32x16{};o[1]=f32x16{};f32x16 negm=f32x16{};asm volatile("":"+v"(negm));
  #define CMASK(P0,P1,t) do{}while(0)
  bool resc=false;
  #define START(P0,P1) do{ const float rm=rowmax(P0,P1); resc=false; \
    { const float dl=rm; mhat=fadd_s(mhat,dl); \
      _Pragma("unroll") for(int r=0;r<16;++r){P0[r]=fsub_s(P0[r],dl);P1[r]=fsub_s(P1[r],dl);} \
      _Pragma("unroll") for(int r=0;r<16;++r)negm[r]=-mhat; asm volatile("":"+v"(negm)); } \
    _Pragma("unroll") for(int r=0;r<16;++r)P0[r]=__builtin_amdgcn_exp2f(P0[r]); }while(0)
  #define RESC() do{ if(resc){ asm volatile("s_waitcnt lgkmcnt(0)":::"memory"); \
      _Pragma("unroll") for(int d_=0;d_<2;++d_) _Pragma("unroll") for(int r=0;r<16;++r)o[d_][r]*=wsf[crow(r,hi)]; } }while(0)
  f32x16 pA0,pA1,pB0,pB1;
  int sl_prev=0,sl_cur=0,sl_next=SLOTB;
  #define ROT() do{sl_prev=sl_cur;sl_cur=sl_next;sl_next=(sl_next==(NSLOT-1)*SLOTB)?0:sl_next+SLOTB;}while(0)
  DMA_K(2,2*SLOTB);
  WAIT_BAR(3);
  qkt(pA0,pA1,Kbase,qr,negm,r32,hi);asm volatile("s_nop 15\n\ts_nop 7":"+v"(pA0),"+v"(pA1));CMASK(pA0,pA1,0);
  START(pA0,pA1);
  _Pragma("unroll") for(int r=0;r<16;++r)pA1[r]=__builtin_amdgcn_exp2f(pA1[r]);
  WAIT_BAR(0);
  DMA_K(3,0);DMA_V(1,SLOTB);
  ROT();
  kload8(kf,kp0+sl_cur);
  WAIT_BAR(2);
  s16x4 vlo[8],vhi[8]; u32x4 pw0,pw1,pw2,pw3;
  #define PKW(P,B) cvtpk_s(P[B],P[B+1])
  #define PAF(k) __builtin_bit_cast(bf16x8,pw##k)
  #define VFR(i) (bf16x8){vlo[i][0],vlo[i][1],vlo[i][2],vlo[i][3],vhi[i][0],vhi[i][1],vhi[i][2],vhi[i][3]}
  #define PIN(x) asm volatile("":"+v"(x))
  #define MX3(a,b,c) __builtin_fmaxf(__builtin_fmaxf((a),(b)),(c))
  #define GAPA(MF,A0,A1,A2,A3,W0,W1,PW) do{ MF; sacc+=A0; sacc+=A1; sacc+=A2; sacc+=A3; PIN(sacc); W0; W1; PIN(PW); SBAR(); }while(0)
  #define EX(v) __builtin_amdgcn_exp2f(v)
  #define GAPB(MF,X,B) do{ MF; X[B]=EX(X[B]); X[B+1]=EX(X[B+1]); X[B+2]=EX(X[B+2]); X[B+3]=EX(X[B+3]); PIN(X); SBAR(); }while(0)
  #define VRD(i) do{ vlo[i]=vtr(vp_+(((i)>>2)*4096+((i)&3)*1024)); vhi[i]=vtr(vp_+(((i)>>2)*4096+((i)&3)*1024+512)); }while(0)
  #define KRD(G,j) do{ if(G){ kload2(kf,kp0+sl_next,j); SBAR(); } }while(0)
  #define STEP(C0,C1,P0,P1,t,GK,GV,GL) do{ SBAR(); \
    const lds_cptr vp_=vp0+sl_prev; \
    VRD(0); SBAR(); float sacc=(P0[0]+P0[1]); \
    GAPA(C0=__builtin_amdgcn_mfma_f32_32x32x16_bf16(kf[0],qr[0],negm,0,0,0), P0[2],P0[3],P0[4],P0[5],     pw0[0]=PKW(P0,0), pw0[1]=PKW(P0,2), pw0); \
    VRD(4); SBAR(); GAPA(C1=__builtin_amdgcn_mfma_f32_32x32x16_bf16(kf[1],qr[0],negm,0,0,0), P0[6],P0[7],P0[8],P0[9],     pw0[2]=PKW(P0,4), pw0[3]=PKW(P0,6), pw0); \
    VRD(1); SBAR(); GAPA(C0=__builtin_amdgcn_mfma_f32_32x32x16_bf16(kf[2],qr[1],C0,0,0,0),   P0[10],P0[11],P0[12],P0[13], pw1[0]=PKW(P0,8), pw1[1]=PKW(P0,10), pw1); \
    VRD(5); SBAR(); GAPA(C1=__builtin_amdgcn_mfma_f32_32x32x16_bf16(kf[3],qr[1],C1,0,0,0),   P0[14],P0[15],P1[0],P1[1],   pw1[2]=PKW(P0,12),pw1[3]=PKW(P0,14), pw1); \
    VRD(2); SBAR(); GAPA(C0=__builtin_amdgcn_mfma_f32_32x32x16_bf16(kf[4],qr[2],C0,0,0,0),   P1[2],P1[3],P1[4],P1[5],     pw2[0]=PKW(P1,0), pw2[1]=PKW(P1,2), pw2); \
    VRD(6); SBAR(); GAPA(C1=__builtin_amdgcn_mfma_f32_32x32x16_bf16(kf[5],qr[2],C1,0,0,0),   P1[6],P1[7],P1[8],P1[9],     pw2[2]=PKW(P1,4), pw2[3]=PKW(P1,6), pw2); \
    VRD(3); SBAR(); GAPA(C0=__builtin_amdgcn_mfma_f32_32x32x16_bf16(kf[6],qr[3],C0,0,0,0),   P1[10],P1[11],P1[12],P1[13], pw3[0]=PKW(P1,8), pw3[1]=PKW(P1,10), pw3); \
    VRD(7); SBAR(); GAPA(C1=__builtin_amdgcn_mfma_f32_32x32x16_bf16(kf[7],qr[3],C1,0,0,0),   P1[14],P1[15],0.f,0.f,       pw3[2]=PKW(P1,12),pw3[3]=PKW(P1,14), pw3); \
    l_reg+=sacc; \
    if(GK){DMA_K((t)+3,sl_cur);} if(GV){DMA_V((t)+1,sl_next);} \
    CMASK(C0,C1,t); \
    { float a=MX3(C0[0],C0[1],C1[0]),b=MX3(C0[2],C0[3],C1[1]); a=MX3(a,C1[2],C1[3]); \
      _Pragma("unroll") for(int r=4;r<16;r+=4){a=MX3(a,C0[r],C0[r+1]);b=MX3(b,C0[r+2],C0[r+3]);a=MX3(a,C1[r],C1[r+1]);b=MX3(b,C1[r+2],C1[r+3]);} \
      float rm=__builtin_fmaxf(a,b); { auto rr=__builtin_amdgcn_permlane32_swap(__float_as_uint(rm),__float_as_uint(rm),false,false); rm=__builtin_fmaxf(__uint_as_float(rr[0]),__uint_as_float(rr[1])); } \
      resc=false; \
      if(__builtin_expect(__any(rm>(float)THRL),0)){ const float dl=__builtin_fmaxf(rm,0.f); mhat+=dl; \
        _Pragma("unroll") for(int r=0;r<16;++r){C0[r]-=dl;C1[r]-=dl;} \
        _Pragma("unroll") for(int r=0;r<16;++r)negm[r]=-mhat; asm volatile("":"+v"(negm)); \
        const float f=__builtin_amdgcn_exp2f(-dl); l_reg*=f; if(hi==0)wsf[r32]=f; resc=true; } } \
    SBAR(); \
    GAPB(o[0]=__builtin_amdgcn_mfma_f32_32x32x16_bf16(PAF(0),VFR(0),o[0],0,0,0), C0,0); \
    GAPB(o[1]=__builtin_amdgcn_mfma_f32_32x32x16_bf16(PAF(0),VFR(4),o[1],0,0,0), C0,4); \
    KRD(GL,0); GAPB(o[0]=__builtin_amdgcn_mfma_f32_32x32x16_bf16(PAF(1),VFR(1),o[0],0,0,0), C0,8); \
    KRD(GL,1); GAPB(o[1]=__builtin_amdgcn_mfma_f32_32x32x16_bf16(PAF(1),VFR(5),o[1],0,0,0), C0,12); \
    KRD(GL,2); GAPB(o[0]=__builtin_amdgcn_mfma_f32_32x32x16_bf16(PAF(2),VFR(2),o[0],0,0,0), C1,0); \
    KRD(GL,3); GAPB(o[1]=__builtin_amdgcn_mfma_f32_32x32x16_bf16(PAF(2),VFR(6),o[1],0,0,0), C1,4); \
    GAPB(o[0]=__builtin_amdgcn_mfma_f32_32x32x16_bf16(PAF(3),VFR(3),o[0],0,0,0), C1,8); \
    GAPB(o[1]=__builtin_amdgcn_mfma_f32_32x32x16_bf16(PAF(3),VFR(7),o[1],0,0,0), C1,12); \
    }while(0)
  int t=1;
  for(;t+5<NT;t+=2){
    STEP(pB0,pB1,pA0,pA1,t,true,true,true);     WAIT_BAR(2); RESC(); ROT();
    STEP(pA0,pA1,pB0,pB1,t+1,true,true,true);   WAIT_BAR(2); RESC(); ROT();
  }
  #define ENDW(tt) do{ if((tt)+3<NT){WAIT_BAR(2);} else if((tt)+2<NT){WAIT_BAR(1);} else {WAIT_BAR(0);} }while(0)
  for(;t+1<NT;t+=2){
    STEP(pB0,pB1,pA0,pA1,t,(t+3<NT),(t+1<NT),(t+1<NT));       ENDW(t);   RESC(); ROT();
    STEP(pA0,pA1,pB0,pB1,t+1,(t+4<NT),(t+2<NT),(t+2<NT));     ENDW(t+1); RESC(); ROT();
  }
  STEP(pB0,pB1,pA0,pA1,NT-1,false,false,false); RESC();
  { float sacc=pB0[0]+pB0[1]; _Pragma("unroll") for(int r=2;r<16;++r)sacc+=pB0[r]; _Pragma("unroll") for(int r=0;r<16;++r)sacc+=pB1[r]; l_reg+=sacc;
    pw0=(u32x4){PKW(pB0,0),PKW(pB0,2),PKW(pB0,4),PKW(pB0,6)};pw1=(u32x4){PKW(pB0,8),PKW(pB0,10),PKW(pB0,12),PKW(pB0,14)};pw2=(u32x4){PKW(pB1,0),PKW(pB1,2),PKW(pB1,4),PKW(pB1,6)};pw3=(u32x4){PKW(pB1,8),PKW(pB1,10),PKW(pB1,12),PKW(pB1,14)};
    SBAR(); pv(o,vb0+sl_cur,PAF(0),PAF(1),PAF(2),PAF(3)); }
  #undef PKW
  #undef PAF
  #undef VFR
  #undef PIN
  #undef MX3
  #undef GAPA
  #undef GAPB
  #undef EX
  #undef VRD
  #undef KRD
  #undef STEP
  #undef ENDW
  {auto rr=__builtin_amdgcn_permlane32_swap(__float_as_uint(l_reg),__float_as_uint(l_reg),false,false);l_reg=__uint_as_float(rr[0])+__uint_as_float(rr[1]);}
  if(hi==0)wsf[32+r32]=l_reg;asm volatile("s_waitcnt lgkmcnt(0)":::"memory");
  float rli[16];
  #pragma unroll
  for(int r=0;r<16;++r)rli[r]=__builtin_amdgcn_rcpf(wsf[32+crow(r,hi)]);
  bf16*Ow=Ob+(long)(wid*QBLK)*opitch;
  { bf16*stg=(bf16*)(shm+LDS_OST)+wid*2048;
    #pragma unroll
    for(int r=0;r<16;++r){const int orow=crow(r,hi);
      #pragma unroll
      for(int d0=0;d0<2;++d0)stg[orow*64+d0*32+r32]=__float2bfloat16(o[d0][r]*rli[r]);}
    asm volatile("s_waitcnt lgkmcnt(0)":::"memory");
    #pragma unroll
    for(int i=0;i<4;++i){const int row=i*8+(lane>>3),ch=lane&7; const u32x4 v=*(const u32x4*)(stg+row*64+ch*8); ATTN_STORE16(Ow+(long)row*opitch+ch*8,v);} }
  asm volatile("s_waitcnt lgkmcnt(0)\n\ts_barrier":::"memory");
  #undef DMA_K
  #undef DMA_V
  #undef CMASK
  #undef START
  #undef RESC
  #undef ROT
}
constexpr int ATTN_LDS_BYTES=LDS_BYTES;
#undef SBAR
#undef WAIT_BAR
}
namespace cg = cooperative_groups;
#define LAS __attribute__((address_space(3)))
typedef unsigned short u16;
typedef unsigned v4u __attribute__((ext_vector_type(4)));
typedef unsigned v2u __attribute__((ext_vector_type(2)));
typedef float f32x4 __attribute__((ext_vector_type(4)));
#define LDS_WAIT() asm volatile("s_waitcnt lgkmcnt(0)" ::: "memory")
#define VM_WAIT() asm volatile("s_waitcnt vmcnt(0)" ::: "memory")
__device__ __forceinline__ unsigned f2bf(float f) { unsigned u = __builtin_bit_cast(unsigned, f); return (u + 0x7fffu + ((u >> 16) & 1u)) >> 16; }
__device__ __forceinline__ unsigned pk2(float lo, float hi) { return f2bf(lo) | (f2bf(hi) << 16); }
__device__ __forceinline__ float bflo(unsigned w) { return __uint_as_float(w << 16); }
__device__ __forceinline__ float bfhi(unsigned w) { return __uint_as_float(w & 0xffff0000u); }
__device__ __forceinline__ float wave_sum(float v) {
#pragma unroll
    for (int o = 1; o < 64; o <<= 1) v += __shfl_xor(v, o);
    return v;
}

#define XB_TMO      128
#define XB_XCNT(j)  (256  + 64 * (j))
#define XB_XSUB(j)  (1280 + 64 * (j))
#define XB_XGEN(j)  (2304 + 64 * (j))
#define XB_TOP      3328
#define XB_TOPGEN   3392
#define XCD_BAR_WORDS 3456
#define XB_SPIN_CAP (1u << 18)

__device__ __forceinline__ unsigned xb_ld(unsigned* p)              { return __hip_atomic_load(p, __ATOMIC_RELAXED, __HIP_MEMORY_SCOPE_AGENT); }
__device__ __forceinline__ unsigned xb_add(unsigned* p, unsigned v) { return __hip_atomic_fetch_add(p, v, __ATOMIC_RELAXED, __HIP_MEMORY_SCOPE_AGENT); }
__device__ __forceinline__ unsigned xb_xcc_id() { return (unsigned)__builtin_amdgcn_s_getreg((3 << 11) | 20) & 0xFu; }
#define XB_SPIN(cond, bar) do { unsigned _sp = 0; while (cond) { __builtin_amdgcn_s_sleep(1); \
    if ((++_sp & 255u) == 0u) { if (xb_ld(&(bar)[XB_TMO])) break; if (_sp > XB_SPIN_CAP) { atomicAdd(&(bar)[XB_TMO], 1u); break; } } } } while (0)

struct XcdBarrier {
    unsigned* bar; unsigned x;
    volatile LAS unsigned* st;
};

__device__ __forceinline__ XcdBarrier xcd_barrier_post(unsigned* bar, volatile LAS unsigned* st) {
    XcdBarrier b; b.bar = bar; b.x = xb_xcc_id(); b.st = st;
    if (threadIdx.x == 0) (void)xb_add(&bar[XB_XCNT(b.x)], 1u);
    return b;
}
__device__ __forceinline__ void xcd_barrier_complete(unsigned* bar, unsigned x, unsigned& nloc, unsigned& nx) {
    const unsigned G = gridDim.x * gridDim.y * gridDim.z;
    unsigned sum, cnt, mine, sp = 0u;
    for (;;) {
        sum = 0u; cnt = 0u; mine = 0u;
#pragma unroll
        for (unsigned j = 0; j < 16; ++j) { const unsigned c = xb_ld(&bar[XB_XCNT(j)]); sum += c; cnt += (c > 0u) ? 1u : 0u; mine = (j == x) ? c : mine; }
        if (sum == G) break;
        __builtin_amdgcn_s_sleep(1);
        if ((++sp & 255u) == 0u) { if (xb_ld(&bar[XB_TMO])) break; if (sp > XB_SPIN_CAP) { atomicAdd(&bar[XB_TMO], 1u); break; } }
    }
    nloc = mine > 0u ? mine : 1u; nx = cnt > 0u ? cnt : 1u;
}

__device__ __forceinline__ void xcd_barrier(const XcdBarrier& b) {
    asm volatile("s_waitcnt vmcnt(0)" ::: "memory");
    __syncthreads();
    if (threadIdx.x == 0) {
        unsigned* bar = b.bar;
        __builtin_amdgcn_s_waitcnt(0);
        unsigned nloc = b.st[0], nx = b.st[1];
        if (nloc == 0u) { xcd_barrier_complete(bar, b.x, nloc, nx); b.st[0] = nloc; b.st[1] = nx; }
        const unsigned old = xb_add(&bar[XB_XSUB(b.x)], 1u);
        const unsigned gen = old / nloc;
        if (old + 1u == (gen + 1u) * nloc) {
            __builtin_amdgcn_fence(__ATOMIC_RELEASE, "agent");
            asm volatile("s_waitcnt vmcnt(0)" ::: "memory");
            const unsigned og = xb_add(&bar[XB_TOP], 1u);
            const unsigned tg = og / nx;
            if (og + 1u == (tg + 1u) * nx) xb_add(&bar[XB_TOPGEN], 1u);
            else XB_SPIN(xb_ld(&bar[XB_TOPGEN]) == tg, bar);
            __builtin_amdgcn_fence(__ATOMIC_ACQUIRE, "agent");
            xb_add(&bar[XB_XGEN(b.x)], 1u);
            asm volatile("s_waitcnt vmcnt(0)" ::: "memory");
        } else {
            XB_SPIN(xb_ld(&bar[XB_XGEN(b.x)]) == gen, bar);
            __builtin_amdgcn_fence(__ATOMIC_ACQUIRE, "agent");
            asm volatile("s_waitcnt vmcnt(0)" ::: "memory");
        }
    }
    __syncthreads();
}


constexpr int NWAVES = 8, NTHREADS = 512;
constexpr int DM = 1024, NB = 8, SEQ = 2048, CTXL = 256, MTOK = NB * SEQ, RPB = CTXL + SEQ  , MST = NB * RPB, INW = 2304, DFF = 2816, NMOD = 6 * DM;
constexpr int OFF_AQ = 0, OFF_AK = 512, OFF_AV = 1024, OFF_BQ = 1536, OFF_BK = 2048, OFF_BV = 2176;
constexpr float EPS = 1e-6f;
constexpr size_t MiB = 1u << 20;
constexpr size_t WS_MODS = 1 * MiB, WS_ZERO_BYTES = 2 * MiB;
constexpr size_t WS_ROPEC = 2 * MiB, WS_ROPES = WS_ROPEC + 4096, WS_CS128 = 2 * MiB + 65536;
constexpr size_t WS_WIN = 3 * MiB, WS_WO0 = 8 * MiB, WS_GU0 = 10 * MiB, WS_DN0 = 21 * MiB, WS_WO1 = 27 * MiB, WS_GU1 = 29 * MiB, WS_DN1 = 40 * MiB, WS_WCS = 46 * MiB;
constexpr size_t WS_HC = 62 * MiB, WS_BIG = 98 * MiB, WS_ATT = 186 * MiB, WS_TMP = 218 * MiB, WS_END = 250 * MiB;
constexpr int LDS_BYTES = 147456, LUT_OFF = 131072, MISC_OFF = 131072 + 8192;
constexpr size_t WS_BAR = 4096;
constexpr int NPHASE = 17;

struct Args { const float* in[27]; float* out; unsigned char* ws; int ph_lo, ph_hi; };

__device__ __forceinline__ void p0_transpose_item(const float* W, int K, int N, u16* WT, int mode, int item, int lane) {
    const int nblk = N / 256, kb = item / nblk, nb = item - kb * nblk, k0 = 32 * kb, n0 = 256 * nb + 4 * lane;
    const float* src = W + (size_t)k0 * N + n0;
    f32x4 v[32];
#pragma unroll
    for (int k = 0; k < 32; ++k) v[k] = *(const f32x4*)(src + (size_t)k * N);
#pragma unroll
    for (int e = 0; e < 4; ++e) { const int n = n0 + e; int d = n;
        if (mode == 1) { const int up = n >= DFF, j = up ? n - DFF : n; d = (j >> 7) * 256 + up * 128 + (j & 127); }
        u16* dp = WT + (size_t)d * K + k0;
#pragma unroll
        for (int q = 0; q < 4; ++q) { v4u o; o.x = pk2(v[8 * q][e], v[8 * q + 1][e]); o.y = pk2(v[8 * q + 2][e], v[8 * q + 3][e]); o.z = pk2(v[8 * q + 4][e], v[8 * q + 5][e]); o.w = pk2(v[8 * q + 6][e], v[8 * q + 7][e]);
            *(v4u*)(dp + 8 * q) = o; } }
}

__device__ __forceinline__ const float* norm_src(const float* x, const float* ctx, bool stacked, int R, int& key) {
    if (stacked) { const int b = R / RPB, r = R - b * RPB;
        if (r < CTXL) { key = 8; return ctx + (size_t)(b * CTXL + r) * DM; } key = b; return x + (size_t)(b * SEQ + r - CTXL) * DM; }
    key = R >> 11; return x + (size_t)R * DM;
}
__device__ __forceinline__ void norm_rows(const float* x, const float* ctx, bool stacked, u16* dst, const float* g, const float* mods, int shift_off, int scale_off, int gw, int NGW, int lane) {
    const int nrows = stacked ? MST : MTOK, rpw = (nrows + NGW - 1) / NGW;
    const int R0 = gw * rpw, R1 = (R0 + rpw < nrows) ? R0 + rpw : nrows;
    if (R0 >= R1) return;
    f32x4 gs[4], sh[4]; int curkey = -1, key;
    const float* src = norm_src(x, ctx, stacked, R0, key);
    f32x4 v[4], nv[4];
#pragma unroll
    for (int j = 0; j < 4; ++j) v[j] = ((const f32x4*)src)[64 * j + lane];
    for (int R = R0; R < R1; ++R) {
        int nkey = key;
        if (R + 1 < R1) { const float* nsrc = norm_src(x, ctx, stacked, R + 1, nkey);
#pragma unroll
            for (int j = 0; j < 4; ++j) nv[j] = ((const f32x4*)nsrc)[64 * j + lane]; }
        if (key != curkey) { curkey = key; const float* mrow = mods + (size_t)key * NMOD;
#pragma unroll
            for (int j = 0; j < 4; ++j) { gs[j] = ((const f32x4*)g)[64 * j + lane] * (((const f32x4*)(mrow + scale_off))[64 * j + lane] + 1.0f); sh[j] = ((const f32x4*)(mrow + shift_off))[64 * j + lane]; } }
        float s = 0.f;
#pragma unroll
        for (int j = 0; j < 4; ++j) s += (v[j].x * v[j].x + v[j].y * v[j].y) + (v[j].z * v[j].z + v[j].w * v[j].w);
        const float rstd = 1.0f / sqrtf(wave_sum(s) * (1.0f / DM) + EPS);
        unsigned long long* o8 = (unsigned long long*)(dst + (size_t)R * DM) + lane;
#pragma unroll
        for (int j = 0; j < 4; ++j) { const f32x4 y = v[j] * rstd * gs[j] + sh[j];
            o8[64 * j] = (unsigned long long)pk2(y.x, y.y) | ((unsigned long long)pk2(y.z, y.w) << 32); }
#pragma unroll
        for (int j = 0; j < 4; ++j) v[j] = nv[j];
        key = nkey;
    }
}

__global__ void __launch_bounds__(NTHREADS, 2) mega_fwd(Args args) {
    extern __shared__ __attribute__((aligned(16))) unsigned char lds[];
    LAS unsigned char* L = (LAS unsigned char*)lds;
    const int tid = threadIdx.x, lane = tid & 63, wave = __builtin_amdgcn_readfirstlane(tid >> 6);
    const int G = gridDim.x, bx = blockIdx.x;
    const int vcu = (G % 8 == 0) ? (bx % 8) * (G / 8) + bx / 8 : bx;
    const int gw = vcu * NWAVES + wave, NGW = G * NWAVES;
    unsigned char* ws = args.ws;
    const float* x_in = args.in[0]; float* out = args.out;
    float* mods = (float*)(ws + WS_MODS);
    u16* HC = (u16*)(ws + WS_HC); u16* BIG = (u16*)(ws + WS_BIG); u16* ATT = (u16*)(ws + WS_ATT); u16* TMP = (u16*)(ws + WS_TMP);
    const int lo = args.ph_lo, hi = args.ph_hi;
    volatile LAS unsigned* MISC = (volatile LAS unsigned*)(L + MISC_OFF);
    if (tid < 2) MISC[tid] = 0u;
    __syncthreads();
    XcdBarrier bar = xcd_barrier_post((unsigned*)(ws + WS_BAR), MISC);
#ifndef PHMASK
#define PHMASK 0x1ffff
#endif
#define IN(k) (((PHMASK >> (k)) & 1) && lo <= (k) && (k) < hi)
#ifndef REPMASK
#define REPMASK 0
#endif
#define PH(k) if (IN(k))
#define SEAM(k) do { if (IN((k) + 1)) { if ((k) == 0) cg::this_grid().sync(); else xcd_barrier(bar); } } while (0)

    PH(0) {
        LAS float* lut = (LAS float*)(L + LUT_OFF);
        for (int m = tid; m < 2048; m += NTHREADS) lut[m] = cospif((float)m * (1.0f / 1024.0f));
        __syncthreads();
        for (int it = bx; it < 48; it += G) {
            const int l = it / 24, nc = it % 24; const float* W = args.in[l ? 19 : 4]; const float* bias = args.in[l ? 20 : 5];
            LAS float* sv = (LAS float*)(L + wave * 16384);
            const int k0 = wave * 128;
#pragma unroll
            for (int bb = 0; bb < 9; ++bb)
#pragma unroll
                for (int h = 0; h < 2; ++h) { const int k = k0 + h * 64 + lane; const float v = bb < 8 ? args.in[1][bb * DM + k] : args.in[3][k]; sv[bb * 128 + h * 64 + lane] = v / (1.0f + __expf(-v)); }
            LDS_WAIT(); asm volatile("" ::: "memory");
            f32x4 acc[9];
#pragma unroll
            for (int bb = 0; bb < 9; ++bb) acc[bb] = (f32x4){0.f, 0.f, 0.f, 0.f};
            const float* wp = W + (size_t)k0 * NMOD + nc * 256 + 4 * lane;
#pragma unroll 16
            for (int kk = 0; kk < 128; ++kk) { const f32x4 w = *(const f32x4*)(wp + (size_t)kk * NMOD);
#pragma unroll
                for (int bb = 0; bb < 9; ++bb) acc[bb] += w * sv[bb * 128 + kk]; }
            LDS_WAIT(); asm volatile("" ::: "memory");
            LAS f32x4* red = (LAS f32x4*)(L + wave * 16384);
#pragma unroll
            for (int bb = 0; bb < 9; ++bb) red[bb * 64 + lane] = acc[bb];
            __syncthreads();
            for (int o = tid; o < 9 * 64; o += NTHREADS) { f32x4 s = (f32x4){0.f, 0.f, 0.f, 0.f};
#pragma unroll
                for (int w8 = 0; w8 < 8; ++w8) s += ((LAS f32x4*)(L + w8 * 16384))[o];
                const int bb = o >> 6, ln = o & 63; s += *(const f32x4*)(bias + nc * 256 + 4 * ln);
                *(f32x4*)(mods + (size_t)(l * 9 + bb) * NMOD + nc * 256 + 4 * ln) = s; }
            __syncthreads();
        }
        {
            constexpr int I_IN = 32 * 9, I_O = 32 * 4, I_GU = 32 * 22, I_DN = 88 * 4;
            constexpr int NIT = I_IN + 2 * (I_O + I_GU + I_DN);
            for (int it = gw; it < NIT; it += NGW) {
                int r = it;
                if (r < I_IN) { p0_transpose_item(args.in[7], DM, INW, (u16*)(ws + WS_WIN), 0, r, lane); continue; } r -= I_IN;
                if (r < I_O) { p0_transpose_item(args.in[15], DM, DM, (u16*)(ws + WS_WO0), 0, r, lane); continue; } r -= I_O;
                if (r < I_GU) { p0_transpose_item(args.in[17], DM, 2 * DFF, (u16*)(ws + WS_GU0), 1, r, lane); continue; } r -= I_GU;
                if (r < I_DN) { p0_transpose_item(args.in[18], DFF, DM, (u16*)(ws + WS_DN0), 0, r, lane); continue; } r -= I_DN;
                if (r < I_O) { p0_transpose_item(args.in[22], DM, DM, (u16*)(ws + WS_WO1), 0, r, lane); continue; } r -= I_O;
                if (r < I_GU) { p0_transpose_item(args.in[24], DM, 2 * DFF, (u16*)(ws + WS_GU1), 1, r, lane); continue; } r -= I_GU;
                p0_transpose_item(args.in[25], DFF, DM, (u16*)(ws + WS_DN1), 0, r, lane);
            }
        }
        for (int k = gw; k < 2048; k += NGW) {
            u16* row = (u16*)(ws + WS_WCS) + (size_t)k * 4096;
#pragma unroll 2
            for (int i = 0; i < 8; ++i) { const int e0 = (i * 64 + lane) * 8, cs = e0 >> 11, n0 = e0 & 2047; float v[8];
#pragma unroll
                for (int e = 0; e < 8; ++e) { const int m = (k * (n0 + e)) & 2047; v[e] = cs ? -lut[(m - 512) & 2047] : lut[m]; }
                v4u o; o.x = pk2(v[0], v[1]); o.y = pk2(v[2], v[3]); o.z = pk2(v[4], v[5]); o.w = pk2(v[6], v[7]);
                *(v4u*)(row + e0) = o; }
        }
        for (int i = gw * 64 + lane; i < 256 * 128; i += NGW * 64) { const int r = i >> 7, j = i & 127, cs = r >> 7, jp = r & 127, m = ((jp * j) & 127) * 16;
            ((u16*)(ws + WS_CS128))[i] = (u16)f2bf(cs ? lut[(m - 512) & 2047] : lut[m]); }
        for (int i = gw * 64 + lane; i < 1024; i += NGW * 64) { const int pos = i >> 4, p = i & 15; const float inv = powf(10000.0f, -(float)p / 16.0f), ang = (float)pos * inv;
            ((float*)(ws + WS_ROPEC))[i] = cosf(ang); ((float*)(ws + WS_ROPES))[i] = sinf(ang); }
        SEAM(0);
    }
    PH(1) { norm_rows(x_in, args.in[2], true, HC, args.in[6], mods, 0 * DM, 1 * DM, gw, NGW, lane); SEAM(1); }
    PH(2) {
        pg8::GemmStd g{HC, (const u16*)(ws + WS_WIN), DM, DM, DM}; pg8::StaticOrder S; S.init(MST, INW, G, bx);
        pg8::EpiBf16 E{BIG, INW};
        pg8::gemm_phase<pg8::EpiBf16, pg8::GemmStd, pg8::StaticOrder, true, true>(L, g, S, E);
        SEAM(2);
    }
    PH(3) {
        const float* ropeC = (const float*)(ws + WS_ROPEC); const float* ropeS = (const float*)(ws + WS_ROPES);
        const int sub = lane & 7, hs = lane >> 3, axis = sub >> 2, q4 = sub & 3, dcol = axis * 32 + 4 * q4;
        const f32x4 gq1 = *(const f32x4*)(args.in[13] + dcol), gq2 = *(const f32x4*)(args.in[13] + dcol + 16);
        const f32x4 gk1 = *(const f32x4*)(args.in[14] + dcol), gk2 = *(const f32x4*)(args.in[14] + dcol + 16);
        constexpr float C2 = 0.125f * 1.4426950408889634f;
        for (int R = gw; R < MST; R += NGW) {
            const int b = R / RPB, r = R - b * RPB; const bool isctx = r < CTXL; const int s = r - CTXL;
            const int pos = axis ? (s & 63) : (s >> 6);
            f32x4 cs = (f32x4){1.f, 1.f, 1.f, 1.f}, sn = (f32x4){0.f, 0.f, 0.f, 0.f};
            if (!isctx) { cs = *(const f32x4*)(ropeC + pos * 16 + 4 * q4); sn = *(const f32x4*)(ropeS + pos * 16 + 4 * q4); }
            u16* row = BIG + (size_t)R * INW;
#pragma unroll
            for (int it = 0; it < 4; ++it) {
                if (isctx && it != 3) continue;
                const bool act = (it != 3) || (hs < 2);
                const int col = (it == 0 ? OFF_AQ : it == 1 ? OFF_AK : it == 2 ? OFF_BQ : OFF_BK) + (act ? hs : 0) * 64 + dcol;
                const v2u w1 = *(const v2u*)(row + col), w2 = *(const v2u*)(row + col + 16);
                f32x4 x1 = (f32x4){bflo(w1.x), bfhi(w1.x), bflo(w1.y), bfhi(w1.y)}, x2 = (f32x4){bflo(w2.x), bfhi(w2.x), bflo(w2.y), bfhi(w2.y)};
                if (it >= 2) { float ss = (x1.x * x1.x + x1.y * x1.y) + (x1.z * x1.z + x1.w * x1.w) + (x2.x * x2.x + x2.y * x2.y) + (x2.z * x2.z + x2.w * x2.w);
                    ss += __shfl_xor(ss, 1); ss += __shfl_xor(ss, 2); ss += __shfl_xor(ss, 4);
                    const float rstd = 1.0f / sqrtf(ss * (1.0f / 64.0f) + EPS);
                    x1 = x1 * rstd * (it == 2 ? gq1 : gk1); x2 = x2 * rstd * (it == 2 ? gq2 : gk2); }
                f32x4 o1 = x1 * cs - x2 * sn, o2 = x2 * cs + x1 * sn;
                if (it == 0 || it == 2) { o1 = o1 * C2; o2 = o2 * C2; }
                if (act) { v2u a, c; a.x = pk2(o1.x, o1.y); a.y = pk2(o1.z, o1.w); c.x = pk2(o2.x, o2.y); c.y = pk2(o2.z, o2.w);
                    *(v2u*)(row + col) = a; *(v2u*)(row + col + 16) = c; }
            }
        }
        SEAM(3);
    }
    PH(4) {
        typedef attn_body::bf16 abf;
        const abf* P = (const abf*)BIG;
        for (int s = vcu; s < 256; s += G) {
            const int b = s >> 5, i = s & 31;
            const abf* kvb = P + (size_t)b * RPB * INW;
            for (int r = 0; r < 6; ++r) {
                const abf *Qb, *Kh, *Vh; abf* Ob; int qb;
                if (r < 4) { const int h = i >> 3, m = r >> 1, v = r & 1; qb = i & 7;
                    Qb = kvb + (size_t)(CTXL + qb * 256) * INW + OFF_AQ + h * 128 + m * 64; Kh = kvb + OFF_AK + h * 128 + m * 64; Vh = kvb + OFF_AV + h * 128 + v * 64;
                    Ob = (abf*)TMP + (size_t)(b * SEQ + qb * 256) * DM + h * 256 + m * 128 + v * 64; }
                else { const int u = 2 * i + (r - 4), hq = u >> 3; qb = u & 7;
                    Qb = kvb + (size_t)(CTXL + qb * 256) * INW + OFF_BQ + hq * 64; Kh = kvb + OFF_BK + (hq >> 2) * 64; Vh = kvb + OFF_BV + (hq >> 2) * 64;
                    Ob = (abf*)ATT + (size_t)(b * SEQ + qb * 256) * DM + 512 + hq * 64; }
#ifndef SKIP_ATTN
                attn_body::attn_unit<8>(Qb, Kh, Vh, Ob, (char*)lds);
#endif
            }
        }
        asm volatile("" ::: "memory");
        for (int s = vcu; s < 256; s += G) {
            const int b = s >> 5, i = s & 31, qb = i & 7;
            {
                    VM_WAIT();
                    const float lam = expf(wave_sum(args.in[8][lane] * args.in[9][lane])) - expf(wave_sum(args.in[10][lane] * args.in[11][lane])) + 0.2f;
                    const int h = i >> 3, half = lane >> 5, l32 = lane & 31;
                    const f32x4 sg = *(const f32x4*)(args.in[12] + 4 * l32);
                    const size_t row0 = (size_t)(b * SEQ + qb * 256 + wave * 32);
                    for (int rr = 0; rr < 16; ++rr) { const size_t row = row0 + 2 * rr + half;
                        const unsigned long long* t1 = (const unsigned long long*)(TMP + row * DM + h * 256) + l32;
                        const unsigned long long a = __hip_atomic_load(t1, __ATOMIC_RELAXED, __HIP_MEMORY_SCOPE_AGENT), c = __hip_atomic_load(t1 + 32, __ATOMIC_RELAXED, __HIP_MEMORY_SCOPE_AGENT);
                        const unsigned a0 = (unsigned)a, a1 = (unsigned)(a >> 32), c0 = (unsigned)c, c1 = (unsigned)(c >> 32);
                        f32x4 d = (f32x4){bflo(a0) - lam * bflo(c0), bfhi(a0) - lam * bfhi(c0), bflo(a1) - lam * bflo(c1), bfhi(a1) - lam * bfhi(c1)};
                        float ss = (d.x * d.x + d.y * d.y) + (d.z * d.z + d.w * d.w);
                        ss += __shfl_xor(ss, 1); ss += __shfl_xor(ss, 2); ss += __shfl_xor(ss, 4); ss += __shfl_xor(ss, 8); ss += __shfl_xor(ss, 16);
                        const float rstd = 0.8f / sqrtf(ss * (1.0f / 128.0f) + EPS);
                        d = d * rstd * sg;
                        *(unsigned long long*)(ATT + row * DM + h * 128 + 4 * l32) = (unsigned long long)pk2(d.x, d.y) | ((unsigned long long)pk2(d.z, d.w) << 32); }
            }
        }
        SEAM(4);
    }
    PH(5) {
        pg8::GemmStd g{ATT, (const u16*)(ws + WS_WO0), DM, DM, DM}; pg8::StaticOrder S; S.init(MTOK, DM, G, bx);
        pg8::EpiResGate E{x_in, out, mods + 2 * DM, NMOD};
        pg8::gemm_phase<pg8::EpiResGate, pg8::GemmStd, pg8::StaticOrder, true, true>(L, g, S, E);
        SEAM(5);
    }
    const float* ml0 = mods; const float* ml1 = mods + (size_t)9 * NMOD;
        PH(6) { norm_rows(out, nullptr, false, HC, args.in[16], ml0, 3 * DM, 4 * DM, gw, NGW, lane); SEAM(6); }
        PH(7) {
            pg8::GemmStd g{HC, (const u16*)(ws + (WS_GU0)), DM, DM, DM}; pg8::StaticOrder S; S.init(MTOK, 2 * DFF, G, bx);
            pg8::EpiSwiglu E{BIG, DFF};
            pg8::gemm_phase<pg8::EpiSwiglu, pg8::GemmStd, pg8::StaticOrder, true, true>(L, g, S, E);
            SEAM(7);
        }
        PH(8) {
            pg8::GemmStd g{BIG, (const u16*)(ws + (WS_DN0)), DFF, DFF, DFF}; pg8::StaticOrder S; S.init(MTOK, DM, G, bx);
            pg8::EpiResGate E{out, out, ml0 + 5 * DM, NMOD};
            pg8::gemm_phase<pg8::EpiResGate, pg8::GemmStd, pg8::StaticOrder, true, true>(L, g, S, E);
            SEAM(8);
        }
            PH(9) { norm_rows(out, nullptr, false, HC, args.in[21], ml1, 0 * DM, 1 * DM, gw, NGW, lane); SEAM(9); }
            PH(10) {
                int k128 = 128; asm volatile("" : "+s"(k128));
                pg8::GemmF1 g{(const u16*)(ws + WS_CS128), HC, k128, 128, DM}; pg8::StaticOrder S; S.init(MTOK, 2048, G, bx);
                pg8::EpiF1 E{BIG};
                pg8::gemm_phase<pg8::EpiF1, pg8::GemmF1, pg8::StaticOrder, true, true>(L, g, S, E);
                SEAM(10);
            }
            PH(11) {
                pg8::GemmF2 g{(const u16*)(ws + WS_WCS), BIG, 4096, 4096, 4096}; pg8::StaticOrder S; S.init(MTOK, DM, G, bx);
                pg8::EpiBf16 E{ATT, DM};
                pg8::gemm_phase<pg8::EpiBf16, pg8::GemmF2, pg8::StaticOrder, true, true>(L, g, S, E);
                SEAM(11);
            }
            PH(12) {
                pg8::GemmStd g{ATT, (const u16*)(ws + WS_WO1), DM, DM, DM}; pg8::StaticOrder S; S.init(MTOK, DM, G, bx);
                pg8::EpiResGate E{out, out, ml1 + 2 * DM, NMOD};
                pg8::gemm_phase<pg8::EpiResGate, pg8::GemmStd, pg8::StaticOrder, true, true>(L, g, S, E);
                SEAM(12);
            }
        PH(13) { norm_rows(out, nullptr, false, HC, args.in[23], ml1, 3 * DM, 4 * DM, gw, NGW, lane); SEAM(13); }
        PH(14) {
            pg8::GemmStd g{HC, (const u16*)(ws + (WS_GU1)), DM, DM, DM}; pg8::StaticOrder S; S.init(MTOK, 2 * DFF, G, bx);
            pg8::EpiSwiglu E{BIG, DFF};
            pg8::gemm_phase<pg8::EpiSwiglu, pg8::GemmStd, pg8::StaticOrder, true, true>(L, g, S, E);
            SEAM(14);
        }
        PH(15) {
            pg8::GemmStd g{BIG, (const u16*)(ws + (WS_DN1)), DFF, DFF, DFF}; pg8::StaticOrder S; S.init(MTOK, DM, G, bx);
            pg8::EpiResGate E{out, out, ml1 + 5 * DM, NMOD};
            pg8::gemm_phase<pg8::EpiResGate, pg8::GemmStd, pg8::StaticOrder, true, true>(L, g, S, E);
            SEAM(15);
        }
    PH(16) {
        const float* g = args.in[26];
        for (int R = gw; R < MTOK; R += NGW) {
            f32x4* xr = (f32x4*)(out + (size_t)R * DM) + lane; f32x4 v[4]; float s = 0.f;
#pragma unroll
            for (int j = 0; j < 4; ++j) { v[j] = xr[64 * j]; s += (v[j].x * v[j].x + v[j].y * v[j].y) + (v[j].z * v[j].z + v[j].w * v[j].w); }
            const float rstd = 1.0f / sqrtf(wave_sum(s) * (1.0f / DM) + EPS);
#pragma unroll
            for (int j = 0; j < 4; ++j) xr[64 * j] = v[j] * rstd * ((const f32x4*)g)[64 * j + lane];
        }
    }
#undef IN
#undef SEAM
}

#ifndef MK_MULTI
#define MK_MULTI (REPMASK != 0)
#endif
extern "C" void kernel_launch(void* const* d_in, const int* in_sizes, int n_in, void* d_out, int out_size, void* d_ws, size_t ws_size, hipStream_t stream) {
    static int grid = 0;
    if (grid == 0) {
        if (n_in != 27 || out_size != MTOK * DM || ws_size < WS_END) { fprintf(stderr, "kernel_launch: unexpected shapes (n_in %d out %d ws %zu)\n", n_in, out_size, ws_size); grid = -1; return; }
        int dev = 0, cus = 0, per_cu = 0;
        hipGetDevice(&dev); hipDeviceGetAttribute(&cus, hipDeviceAttributeMultiprocessorCount, dev);
        hipFuncSetAttribute((const void*)mega_fwd, hipFuncAttributeMaxDynamicSharedMemorySize, LDS_BYTES);
        hipOccupancyMaxActiveBlocksPerMultiprocessor(&per_cu, (const void*)mega_fwd, NTHREADS, LDS_BYTES);
        if (per_cu < 1) { fprintf(stderr, "kernel_launch: occupancy query says %d blocks/CU\n", per_cu); per_cu = 1; }
        grid = cus * 1;
        (void)hipGetLastError();
    }
    if (grid < 0) return;
    if (hipMemsetAsync((char*)d_ws, 0, 65536, stream) != hipSuccess) { fprintf(stderr, "kernel_launch: memset failed\n"); return; }
    Args a{};
    for (int i = 0; i < 27; ++i) a.in[i] = (const float*)d_in[i];
    a.out = (float*)d_out; a.ws = (unsigned char*)d_ws;
#if MK_MULTI
    for (int p = 0; p < NPHASE; ++p) for (int rep = 0; rep < ((((REPMASK) >> p) & 1) ? 2 : 1); ++rep) { a.ph_lo = p; a.ph_hi = p + 1; hipLaunchKernelGGL(mega_fwd, dim3(grid), dim3(NTHREADS), LDS_BYTES, stream, a); }
#else
    a.ph_lo = 0; a.ph_hi = NPHASE;
    void* kargs[] = {&a};
    hipError_t e = hipLaunchCooperativeKernel((const void*)mega_fwd, dim3(grid), dim3(NTHREADS), kargs, LDS_BYTES, stream);
    if (e != hipSuccess) fprintf(stderr, "cooperative launch failed: %s (grid %d)\n", hipGetErrorString(e), grid);
#endif
}
```

```cpp
#include <hip/hip_runtime.h>
#include <hip/hip_cooperative_groups.h>
#include <hip/hip_bf16.h>
#include <cstdio>
#include <cstdint>
#include <cmath>
namespace pg8 {
#define PG8_LAS __attribute__((address_space(3)))
typedef unsigned short bf16_t;
typedef short bf16x8 __attribute__((ext_vector_type(8)));
typedef float f32x4 __attribute__((ext_vector_type(4)));
typedef unsigned u32x4 __attribute__((ext_vector_type(4)));
constexpr int BM = 256, BK = 64, HALF = 128, HTB = HALF * BK * 2  , STAGE_BYTES = 8 * HTB, NXCD = 8, WGM = 8;

__host__ __device__ __forceinline__ int lds_byte(int r, int c) { const int st = (r >> 4) * 2 + (c >> 5), rr = r & 15, cc = c & 31, ob = rr * 64 + cc * 2; return st * 1024 + (ob ^ (((ob >> 9) & 1) << 5)); }
__host__ __device__ __forceinline__ void stage_rc(int b, int& R, int& C) { const int st = b / 1024, sb = b % 1024, swz = sb ^ (((sb >> 9) & 1) << 5); R = (st >> 1) * 16 + swz / 64; C = (st & 1) * 32 + (swz % 64) / 2; }
__host__ __device__ __forceinline__ int perm32(int rho) { const int n = rho >> 4, i = rho & 15; return 8 * (i >> 2) + 4 * n + (i & 3); }
struct Unit { int pm, pn; };
struct Gemm { const bf16_t* A; const bf16_t* Bt; int M, N, K; };

struct StaticOrder {
    int nM, nN, nwg, G, c;
    __host__ __device__ void init(int M, int N, int G_, int c_) { nM = M / BM; nN = N / BM; nwg = nM * nN; G = G_; c = c_; }
    __host__ __device__ bool next(int i, Unit& u) const {
        const long L = (long)i * G + c; if (L >= nwg) return false;
        int wgid = (int)L; { const int q = nwg / NXCD, r = nwg % NXCD, xcd = wgid % NXCD, off = wgid / NXCD; wgid = (xcd < r ? xcd * (q + 1) : r * (q + 1) + (xcd - r) * q) + off; }
        const int nig = WGM * nN, gid = wgid / nig, fm = gid * WGM, gsz = (nM - fm) < WGM ? (nM - fm) : WGM;
        u.pm = fm + ((wgid % nig) % gsz); u.pn = (wgid % nig) / gsz; return true;
    }
    __device__ __forceinline__ void a_ready(const Unit&) const {}
    __device__ __forceinline__ void done(const Unit&) const {}
};
__device__ __forceinline__ unsigned cvt_pk_bf16(float lo, float hi) { unsigned r; asm volatile("v_cvt_pk_bf16_f32 %0, %1, %2" : "=v"(r) : "v"(lo), "v"(hi)); return r; }
typedef float f32x2 __attribute__((ext_vector_type(2)));
struct GemmStd { const bf16_t* A; const bf16_t* Bt; int K, lda, ldb;
    __device__ __forceinline__ const char* aptr(const Unit& u) const { return (const char*)A + (size_t)u.pm * BM * lda * 2; }
    __device__ __forceinline__ const char* bptr(const Unit& u) const { return (const char*)Bt + (size_t)u.pn * BM * ldb * 2; } };
struct GemmF1 { const bf16_t* A; const bf16_t* Bt; int K, lda, ldb;
    __device__ __forceinline__ const char* aptr(const Unit&) const { return (const char*)A; }
    __device__ __forceinline__ const char* bptr(const Unit& u) const { return (const char*)Bt + ((size_t)((u.pm >> 3) * 2048 + u.pn * 256) * 1024 + (size_t)(u.pm & 7) * 128) * 2; } };
struct GemmF2 { const bf16_t* A; const bf16_t* Bt; int K, lda, ldb;
    __device__ __forceinline__ const char* aptr(const Unit& u) const { return (const char*)A + (size_t)(u.pm & 7) * 256 * 2048 * 2; }
    __device__ __forceinline__ const char* bptr(const Unit& u) const { return (const char*)Bt + (((size_t)(u.pm >> 3) * 1024 + (size_t)u.pn * 256) * 4096 + (size_t)((u.pm >> 2) & 1) * 2048) * 2; } };

struct EpiBf16 {
    static constexpr bool PERM = true, AFTER_DRAIN = false;
    bf16_t* O; int ldc;
    __device__ __forceinline__ void operator()(const f32x4 (&acc)[2][2][4][2], const Unit& u, int wr, int wc, int fr, int fq) const {
        const int row0 = u.pm * BM + wr * 64 + fr, col0 = u.pn * BM + wc * 32 + 8 * fq;
#pragma unroll
        for (int ai = 0; ai < 2; ++ai)
#pragma unroll
            for (int m = 0; m < 4; ++m) { bf16_t* rowp = O + (size_t)(row0 + ai * HALF + m * 16) * ldc + col0;
#pragma unroll
                for (int bj = 0; bj < 2; ++bj) { const f32x4 v0 = acc[ai][bj][m][0], v1 = acc[ai][bj][m][1];
                    u32x4 w; w.x = cvt_pk_bf16(v0[0], v0[1]); w.y = cvt_pk_bf16(v0[2], v0[3]); w.z = cvt_pk_bf16(v1[0], v1[1]); w.w = cvt_pk_bf16(v1[2], v1[3]);
                    *(u32x4*)(rowp + bj * HALF) = w; } }
    }
};
struct EpiF1 {
    static constexpr bool PERM = true, AFTER_DRAIN = false;
    bf16_t* YT;
    __device__ __forceinline__ void operator()(const f32x4 (&acc)[2][2][4][2], const Unit& u, int wr, int wc, int fr, int fq) const {
        const int b = u.pm >> 3, g = u.pm & 7; const float sc = 1.0f / 512.0f;
        const int col0 = u.pn * BM + wc * 32 + 8 * fq;
#pragma unroll
        for (int ai = 0; ai < 2; ++ai)
#pragma unroll
            for (int m = 0; m < 4; ++m) { bf16_t* rowp = YT + ((size_t)(b * 1024 + g * 128 + wr * 64 + m * 16 + fr)) * 4096 + ai * 2048 + col0;
#pragma unroll
                for (int bj = 0; bj < 2; ++bj) { const f32x4 v0 = acc[ai][bj][m][0] * sc, v1 = acc[ai][bj][m][1] * sc;
                    u32x4 w; w.x = cvt_pk_bf16(v0[0], v0[1]); w.y = cvt_pk_bf16(v0[2], v0[3]); w.z = cvt_pk_bf16(v1[0], v1[1]); w.w = cvt_pk_bf16(v1[2], v1[3]);
                    *(u32x4*)(rowp + bj * HALF) = w; }
                asm volatile("" ::: "memory"); }
    }
};
__device__ __forceinline__ float silu_mul(float g, float u) { return g * u * __builtin_amdgcn_rcpf(1.0f + __builtin_amdgcn_exp2f(-1.4426950408889634f * g)); }
struct EpiSwiglu {
    static constexpr bool PERM = true, AFTER_DRAIN = false;
    bf16_t* O; int ldc;
    __device__ __forceinline__ void operator()(const f32x4 (&acc)[2][2][4][2], const Unit& u, int wr, int wc, int fr, int fq) const {
        const int row0 = u.pm * BM + wr * 64 + fr, col0 = u.pn * HALF + wc * 32 + 8 * fq;
#pragma unroll
        for (int ai = 0; ai < 2; ++ai)
#pragma unroll
            for (int m = 0; m < 4; ++m) { bf16_t* rowp = O + (size_t)(row0 + ai * HALF + m * 16) * ldc + col0;
                const f32x4 g0 = acc[ai][0][m][0], g1 = acc[ai][0][m][1], u0 = acc[ai][1][m][0], u1 = acc[ai][1][m][1];
                u32x4 w; w.x = cvt_pk_bf16(silu_mul(g0[0], u0[0]), silu_mul(g0[1], u0[1])); w.y = cvt_pk_bf16(silu_mul(g0[2], u0[2]), silu_mul(g0[3], u0[3]));
                w.z = cvt_pk_bf16(silu_mul(g1[0], u1[0]), silu_mul(g1[1], u1[1])); w.w = cvt_pk_bf16(silu_mul(g1[2], u1[2]), silu_mul(g1[3], u1[3]));
                *(u32x4*)rowp = w; }
    }
};
struct EpiResGate {
    static constexpr bool PERM = false, AFTER_DRAIN = false;
    const float* base; float* out; const float* gate; int gstride;
    __device__ __forceinline__ void operator()(const f32x4 (&acc)[2][2][4][2], const Unit& u, int wr, int wc, int fr, int fq) const {
        const int col0 = u.pn * BM + wc * 32 + 4 * fq; const float* gp = gate + (size_t)(u.pm >> 3) * gstride + col0;
        f32x4 gv[2][2];
#pragma unroll
        for (int bj = 0; bj < 2; ++bj)
#pragma unroll
            for (int n = 0; n < 2; ++n) gv[bj][n] = *(const f32x4*)(gp + bj * HALF + n * 16);
#pragma unroll
        for (int ai = 0; ai < 2; ++ai)
#pragma unroll
            for (int m = 0; m < 4; ++m) { const size_t off = (size_t)(u.pm * BM + ai * HALF + wr * 64 + m * 16 + fr) * 1024 + col0;
#pragma unroll
                for (int bj = 0; bj < 2; ++bj)
#pragma unroll
                    for (int n = 0; n < 2; ++n) { const f32x4 bs = *(const f32x4*)(base + off + bj * HALF + n * 16); *(f32x4*)(out + off + bj * HALF + n * 16) = bs + gv[bj][n] * acc[ai][bj][m][n]; }
                if (m & 1) asm volatile("" ::: "memory"); }
    }
};
template <class Epi, class G, class Sched, bool ALIGN_EPI = false, bool SP2 = false>
__device__ __forceinline__ void gemm_phase(PG8_LAS unsigned char* lds, const G g, const Sched& S, const Epi& E) {
    const int tid = threadIdx.x, wid = __builtin_amdgcn_readfirstlane(tid >> 6), lane = tid & 63, wr = wid >> 2, wc = wid & 3, fr = lane & 15, fq = lane >> 4;
    const int K = g.K, nt = K / BK;
    unsigned voffA[2], voffB[2];
#pragma unroll
    for (int i = 0; i < 2; ++i) { int R, C; stage_rc(tid * 16 + i * 8192, R, C); const int Rb = Epi::PERM ? ((R & ~31) + perm32(R & 31)) : R;
        voffA[i] = (unsigned)(R * g.lda + C) * 2u; voffB[i] = (unsigned)(Rb * g.ldb + C) * 2u; }
    const size_t kstep = (size_t)(BK * 2);
    const size_t hstepA = (size_t)HALF * g.lda * 2, hstepB = (size_t)HALF * g.ldb * 2;
    const unsigned ldsw = (unsigned)wid * 1024u;
    const int aoff = lds_byte(wr * 64 + fr, fq * 8), boff = lds_byte(wc * 32 + fr, fq * 8);
#define PG8_SA(b, h) (((b) * 2 + (h)) * HTB)
#define PG8_SB(b, h) ((4 + (b) * 2 + (h)) * HTB)
#define PG8_STAGE(bufoff, gbase, voff) do { _Pragma("unroll") for (int _i = 0; _i < 2; ++_i) \
        __builtin_amdgcn_global_load_lds((const unsigned*)((const char*)(gbase) + (voff)[_i]), (PG8_LAS unsigned*)(lds + (bufoff) + ldsw + _i * 8192), 16, 0, 0); } while (0)
#define PG8_LDA(dst, b, h) do { _Pragma("unroll") for (int m = 0; m < 4; ++m) _Pragma("unroll") for (int k = 0; k < 2; ++k) dst[m][k] = *(const PG8_LAS bf16x8*)(lds + PG8_SA(b, h) + aoff + m * 2048 + k * 1024); } while (0)
#define PG8_LDB(dst, b, h) do { _Pragma("unroll") for (int n = 0; n < 2; ++n) _Pragma("unroll") for (int k = 0; k < 2; ++k) dst[n][k] = *(const PG8_LAS bf16x8*)(lds + PG8_SB(b, h) + boff + n * 2048 + k * 1024); } while (0)
#define PG8_MMA(ai, bj, At, Bt) do { __builtin_amdgcn_s_setprio(1); _Pragma("unroll") for (int m = 0; m < 4; ++m) _Pragma("unroll") for (int n = 0; n < 2; ++n) _Pragma("unroll") for (int k = 0; k < 2; ++k) \
        acc[ai][bj][m][n] = __builtin_amdgcn_mfma_f32_16x16x32_bf16(Bt[n][k], At[m][k], acc[ai][bj][m][n], 0, 0, 0); __builtin_amdgcn_s_setprio(0); } while (0)
#define PG8_WAIT_V(n) asm volatile("s_waitcnt vmcnt(" #n ")" ::: "memory")
#define PG8_WAIT_L(n) asm volatile("s_waitcnt lgkmcnt(" #n ")" ::: "memory")
#define PG8_BAR __builtin_amdgcn_s_barrier()
#define PG8_SCHED __builtin_amdgcn_sched_barrier(0)
    Unit cur, nxt; int ui = 0;
    if (!S.next(0, cur)) return;
    f32x4 acc[2][2][4][2];
#pragma unroll
    for (int a = 0; a < 2; ++a)
#pragma unroll
        for (int b = 0; b < 2; ++b)
#pragma unroll
            for (int m = 0; m < 4; ++m)
#pragma unroll
                for (int n = 0; n < 2; ++n) acc[a][b][m][n] = (f32x4){0.f, 0.f, 0.f, 0.f};
    bf16x8 At[4][2], B0[2][2], B1[2][2];
    const char* cA = g.aptr(cur); const char* cB = g.bptr(cur);
    S.a_ready(cur);
    if constexpr (SP2) {
        PG8_STAGE(PG8_SB(0, 0), cB, voffB); PG8_STAGE(PG8_SB(0, 1), cB + hstepB, voffB); PG8_STAGE(PG8_SA(0, 0), cA, voffA); PG8_STAGE(PG8_SA(0, 1), cA + hstepA, voffA);
        if (wr == 1) PG8_BAR;
        PG8_WAIT_V(2); PG8_BAR;
        PG8_STAGE(PG8_SB(1, 0), cB + kstep, voffB); PG8_STAGE(PG8_SA(1, 0), cA + kstep, voffA); PG8_STAGE(PG8_SB(1, 1), cB + hstepB + kstep, voffB);
        PG8_WAIT_V(6); PG8_BAR;
    } else {
        PG8_STAGE(PG8_SB(0, 0), cB, voffB); PG8_STAGE(PG8_SA(0, 0), cA, voffA); PG8_STAGE(PG8_SB(0, 1), cB + hstepB, voffB); PG8_STAGE(PG8_SA(0, 1), cA + hstepA, voffA);
        if (wr == 1) PG8_BAR;
        PG8_WAIT_V(4); PG8_BAR;
        PG8_STAGE(PG8_SB(1, 0), cB + kstep, voffB); PG8_STAGE(PG8_SA(1, 0), cA + kstep, voffA); PG8_STAGE(PG8_SB(1, 1), cB + hstepB + kstep, voffB);
        PG8_WAIT_V(6); PG8_BAR;
    }
    for (;;) {
        const bool has_next = S.next(ui + 1, nxt);
        const char* nA = has_next ? g.aptr(nxt) : cA; const char* nB = has_next ? g.bptr(nxt) : cB;
        for (int t = 0; t < nt; t += 2) {
            const bool last = (t == nt - 2);
            const char* a1 = cA + (size_t)(t + 1) * kstep;
            const char* a2 = last ? nA : cA + (size_t)(t + 2) * kstep; const char* b2 = last ? nB : cB + (size_t)(t + 2) * kstep;
            const char* a3 = a2 + kstep; const char* b3 = b2 + kstep;
            if (last && has_next) S.a_ready(nxt);
            if constexpr (SP2) {
            PG8_LDB(B0, 0, 0); PG8_LDB(B1, 0, 1); PG8_SCHED; PG8_LDA(At, 0, 0); PG8_STAGE(PG8_SA(1, 1), a1 + hstepA, voffA);
            PG8_WAIT_V(8); PG8_WAIT_L(0); PG8_BAR; PG8_MMA(0, 0, At, B0); PG8_MMA(0, 1, At, B1); PG8_BAR; PG8_SCHED;
            PG8_LDA(At, 0, 1); PG8_STAGE(PG8_SB(0, 0), b2, voffB); PG8_STAGE(PG8_SB(0, 1), b2 + hstepB, voffB); PG8_STAGE(PG8_SA(0, 0), a2, voffA);
            PG8_WAIT_V(8); PG8_WAIT_L(0); PG8_BAR; PG8_MMA(1, 0, At, B0); PG8_MMA(1, 1, At, B1); PG8_BAR; PG8_SCHED;
            PG8_LDB(B0, 1, 0); PG8_LDB(B1, 1, 1); PG8_SCHED; PG8_LDA(At, 1, 0); PG8_STAGE(PG8_SA(0, 1), a2 + hstepA, voffA);
            PG8_WAIT_V(8); PG8_WAIT_L(0); PG8_BAR; PG8_MMA(0, 0, At, B0); PG8_MMA(0, 1, At, B1); PG8_BAR; PG8_SCHED;
            PG8_LDA(At, 1, 1); PG8_STAGE(PG8_SB(1, 0), b3, voffB); PG8_STAGE(PG8_SB(1, 1), b3 + hstepB, voffB); PG8_STAGE(PG8_SA(1, 0), a3, voffA);
            PG8_WAIT_V(8); PG8_WAIT_L(0); PG8_BAR; PG8_MMA(1, 0, At, B0); PG8_MMA(1, 1, At, B1); PG8_BAR; PG8_SCHED;
            } else {
            PG8_LDB(B0, 0, 0); PG8_SCHED; PG8_LDA(At, 0, 0); PG8_STAGE(PG8_SA(1, 1), a1 + hstepA, voffA);
            PG8_WAIT_L(8); PG8_BAR; PG8_WAIT_L(0); PG8_MMA(0, 0, At, B0); PG8_BAR; PG8_SCHED;
            PG8_LDB(B1, 0, 1); PG8_STAGE(PG8_SB(0, 0), b2, voffB);
            PG8_BAR; PG8_WAIT_L(0); PG8_MMA(0, 1, At, B1); PG8_BAR;
            PG8_LDA(At, 0, 1); PG8_STAGE(PG8_SA(0, 0), a2, voffA);
            PG8_BAR; PG8_WAIT_L(0); PG8_MMA(1, 0, At, B0); PG8_BAR; PG8_SCHED;
            PG8_STAGE(PG8_SB(0, 1), b2 + hstepB, voffB);
            PG8_WAIT_V(6); PG8_BAR; PG8_MMA(1, 1, At, B1); PG8_BAR;
            PG8_LDB(B0, 1, 0); PG8_SCHED; PG8_LDA(At, 1, 0); PG8_STAGE(PG8_SA(0, 1), a2 + hstepA, voffA);
            PG8_WAIT_L(8); PG8_BAR; PG8_WAIT_L(0); PG8_MMA(0, 0, At, B0); PG8_BAR; PG8_SCHED;
            PG8_LDB(B1, 1, 1); PG8_STAGE(PG8_SB(1, 0), b3, voffB);
            PG8_BAR; PG8_WAIT_L(0); PG8_MMA(0, 1, At, B1); PG8_BAR;
            PG8_LDA(At, 1, 1); PG8_STAGE(PG8_SA(1, 0), a3, voffA);
            PG8_BAR; PG8_WAIT_L(0); PG8_MMA(1, 0, At, B0); PG8_BAR; PG8_SCHED;
            PG8_STAGE(PG8_SB(1, 1), b3 + hstepB, voffB);
            PG8_WAIT_V(6); PG8_BAR; PG8_MMA(1, 1, At, B1); PG8_BAR;
            }
        }
        if constexpr (ALIGN_EPI) { if (wr == 0) PG8_BAR; }
        if constexpr (!Epi::AFTER_DRAIN) { E(acc, cur, wr, wc, fr, fq); S.done(cur); }
        if (!has_next) break;
#pragma unroll
        for (int a = 0; a < 2; ++a)
#pragma unroll
            for (int b = 0; b < 2; ++b)
#pragma unroll
                for (int m = 0; m < 4; ++m)
#pragma unroll
                    for (int n = 0; n < 2; ++n) acc[a][b][m][n] = (f32x4){0.f, 0.f, 0.f, 0.f};
        cur = nxt; cA = nA; cB = nB; ++ui;
        if constexpr (ALIGN_EPI) { if (wr == 1) PG8_BAR; }
    }
    PG8_WAIT_V(0);
    if constexpr (!ALIGN_EPI) { if (wr == 0) PG8_BAR; }
    PG8_BAR;
    if constexpr (Epi::AFTER_DRAIN) { E.fused(acc, cur, wr, wc, fr, fq, lds, wid, lane); S.done(cur); }
#undef PG8_SA
#undef PG8_SB
#undef PG8_STAGE
#undef PG8_LDA
#undef PG8_LDB
#undef PG8_MMA
#undef PG8_WAIT_V
#undef PG8_WAIT_L
#undef PG8_BAR
#undef PG8_SCHED
}
}
namespace attn_body {
using bf16=__hip_bfloat16;
using bf16x8=__attribute__((ext_vector_type(8)))short;
using s16x4=__attribute__((ext_vector_type(4)))short;
using f32x16=__attribute__((ext_vector_type(16)))float;
using u32x4=__attribute__((ext_vector_type(4)))unsigned;
constexpr int D=64,DM=2304,NKEYS=2304;
constexpr int NW=8,QBLK=32,QB=QBLK*NW,KVBLK=64;
__device__ __forceinline__ int crow(int r,int hi){return (r&3)+8*(r>>2)+4*hi;}
#define SBAR() __builtin_amdgcn_sched_barrier(0)
__device__ __forceinline__ void cmask(f32x16&p0,f32x16&p1,int jb,int qrel,int hi){
  const float NEG=-INFINITY; int kb=64*jb+4*hi;
  #pragma unroll
  for(int r=0;r<16;++r){int kv=kb+(r&3)+8*(r>>2); if(kv>qrel)p0[r]=NEG; if(kv+32>qrel)p1[r]=NEG;}
}

constexpr int NSLOT=3, SLOTB=8192;
constexpr int LDS_K=0, LDS_V=NSLOT*SLOTB, LDS_WS=2*NSLOT*SLOTB, LDS_OST=LDS_WS+NW*64*4, LDS_BYTES=LDS_OST+NW*4096;
constexpr float C2=0.125f*1.4426950408889634f;
__device__ __forceinline__ void glds16(const void*gsrc,unsigned lds_dst){unsigned keep;
  asm volatile("s_mov_b32 %0, m0\n\ts_mov_b32 m0, %2\n\ts_nop 0\n\tglobal_load_lds_dwordx4 %1, off\n\ts_mov_b32 m0, %0":"=&s"(keep):"v"(gsrc),"s"(lds_dst):"memory");}
__device__ __forceinline__ float max3f(float a,float b,float c){float r;asm("v_max3_f32 %0, %1, %2, %3":"=v"(r):"v"(a),"v"(b),"v"(c));return r;}
__device__ __forceinline__ float max2f(float a,float b){float r;asm("v_max_f32_e32 %0, %1, %2":"=v"(r):"v"(a),"v"(b));return r;}
__device__ __forceinline__ float fadd_s(float a,float b){float r;asm("v_add_f32_e32 %0, %1, %2":"=v"(r):"v"(a),"v"(b));return r;}
__device__ __forceinline__ float fsub_s(float a,float b){float r;asm("v_sub_f32_e32 %0, %1, %2":"=v"(r):"v"(a),"v"(b));return r;}
typedef float f32x2_t __attribute__((ext_vector_type(2))); typedef __bf16 bf16x2_t __attribute__((ext_vector_type(2)));
__device__ __forceinline__ unsigned cvtpk_s(float lo,float hi){f32x2_t v={lo,hi};bf16x2_t b=__builtin_convertvector(v,bf16x2_t);return __builtin_bit_cast(unsigned,b);}
#define WAIT_BAR(N) asm volatile("s_waitcnt vmcnt(" #N ") lgkmcnt(0)\n\ts_barrier":::"memory")

__device__ __forceinline__ void qkt(f32x16&p0,f32x16&p1,const char*Kslot,const bf16x8*qr,const f32x16&negm,int r32,int hi){
  const char*kb=Kslot+hi*1024+r32*16;
  #pragma unroll
  for(int d0=0;d0<4;++d0){
    const bf16x8 b0=*reinterpret_cast<const bf16x8*>(kb+d0*2048);
    const bf16x8 b1=*reinterpret_cast<const bf16x8*>(kb+d0*2048+512);
    if(d0==0){p0=__builtin_amdgcn_mfma_f32_32x32x16_bf16(b0,qr[0],negm,0,0,0);p1=__builtin_amdgcn_mfma_f32_32x32x16_bf16(b1,qr[0],negm,0,0,0);}
    else{p0=__builtin_amdgcn_mfma_f32_32x32x16_bf16(b0,qr[d0],p0,0,0,0);p1=__builtin_amdgcn_mfma_f32_32x32x16_bf16(b1,qr[d0],p1,0,0,0);}}
}
typedef __attribute__((address_space(3))) const char* lds_cptr;
typedef short v4i16_t __attribute__((ext_vector_type(4)));
__device__ __forceinline__ void kload8(bf16x8*kf,lds_cptr kp){
  kf[0]=*(const __attribute__((address_space(3))) bf16x8*)(kp);      kf[1]=*(const __attribute__((address_space(3))) bf16x8*)(kp+512);
  kf[2]=*(const __attribute__((address_space(3))) bf16x8*)(kp+2048); kf[3]=*(const __attribute__((address_space(3))) bf16x8*)(kp+2560);
  kf[4]=*(const __attribute__((address_space(3))) bf16x8*)(kp+4096); kf[5]=*(const __attribute__((address_space(3))) bf16x8*)(kp+4608);
  kf[6]=*(const __attribute__((address_space(3))) bf16x8*)(kp+6144); kf[7]=*(const __attribute__((address_space(3))) bf16x8*)(kp+6656);
}
__device__ __forceinline__ void kload2(bf16x8*kf,lds_cptr kp,int j){ kf[2*j]=*(const __attribute__((address_space(3))) bf16x8*)(kp+j*2048); kf[2*j+1]=*(const __attribute__((address_space(3))) bf16x8*)(kp+j*2048+512); }
__device__ __forceinline__ s16x4 vtr(lds_cptr p){ return __builtin_bit_cast(s16x4,__builtin_amdgcn_ds_read_tr16_b64_v4i16((__attribute__((address_space(3))) v4i16_t*)p)); }
__device__ __forceinline__ float rowmax(const f32x16&p0,const f32x16&p1){
  float a=max3f(p0[0],p0[1],p1[0]),b=max3f(p0[2],p0[3],p1[1]);a=max3f(a,p1[2],p1[3]);
  #pragma unroll
  for(int r=4;r<16;r+=4){a=max3f(a,p0[r],p0[r+1]);b=max3f(b,p0[r+2],p0[r+3]);a=max3f(a,p1[r],p1[r+1]);b=max3f(b,p1[r+2],p1[r+3]);}
  const float m=max2f(a,b);
  auto rr=__builtin_amdgcn_permlane32_swap(__float_as_uint(m),__float_as_uint(m),false,false);
  return max2f(__uint_as_float(rr[0]),__uint_as_float(rr[1]));
}
__device__ __forceinline__ void pv(f32x16*o,int vb,bf16x8 pa0,bf16x8 pa1,bf16x8 pa2,bf16x8 pa3){
  #pragma unroll
  for(int d0=0;d0<2;++d0){s16x4 lo[4],hi[4];
    #pragma unroll
    for(int ks=0;ks<4;++ks){
      asm volatile("ds_read_b64_tr_b16 %0,%1 offset:%c2":"=&v"(lo[ks]):"v"(vb),"i"(d0*4096+ks*1024):"memory");
      asm volatile("ds_read_b64_tr_b16 %0,%1 offset:%c2":"=&v"(hi[ks]):"v"(vb),"i"(d0*4096+ks*1024+512):"memory");}
    asm volatile("s_waitcnt lgkmcnt(0)":::"memory");SBAR();
    #define PK(k) (bf16x8){lo[k][0],lo[k][1],lo[k][2],lo[k][3],hi[k][0],hi[k][1],hi[k][2],hi[k][3]}
    o[d0]=__builtin_amdgcn_mfma_f32_32x32x16_bf16(pa0,PK(0),o[d0],0,0,0);
    o[d0]=__builtin_amdgcn_mfma_f32_32x32x16_bf16(pa1,PK(1),o[d0],0,0,0);
    o[d0]=__builtin_amdgcn_mfma_f32_32x32x16_bf16(pa2,PK(2),o[d0],0,0,0);
    o[d0]=__builtin_amdgcn_mfma_f32_32x32x16_bf16(pa3,PK(3),o[d0],0,0,0);
    #undef PK
  }
}

#ifndef ATTN_STORE16
#define ATTN_STORE16(p,v) (*(u32x4*)(p)=(v))
#endif
template<int THRL> __device__ __forceinline__ void attn_unit(const bf16*Qb,const bf16*__restrict__ Kh,const bf16*__restrict__ Vh,bf16*Ob,char*shm){
  constexpr int opitch=1024;
  const int tid=threadIdx.x,lane=tid&63,r32=lane&31,hi=lane>>5; const int wid=__builtin_amdgcn_readfirstlane(tid>>6);
  const bf16*Qw=Qb+(long)(wid*QBLK)*DM;
  const unsigned lds0=(unsigned)(uintptr_t)shm;
  float*wsf=(float*)(shm+LDS_WS)+wid*64;
  const bf16*ksrc=Kh+(long)lane*DM+wid*8;
  const bf16*vsrc=Vh+(long)(16*(wid&3)+(lane>>2))*DM+(wid>>2)*32+(lane&3)*8;
  const unsigned kdst=lds0+LDS_K+wid*1024, vdst=lds0+LDS_V+wid*1024;
  #define DMA_K(t,slot) glds16(ksrc+(long)(t)*KVBLK*DM,(unsigned)__builtin_amdgcn_readfirstlane(kdst+(slot)))
  #define DMA_V(t,slot) glds16(vsrc+(long)(t)*KVBLK*DM,(unsigned)__builtin_amdgcn_readfirstlane(vdst+(slot)))
  const int vb0=(int)(lds0+LDS_V)+((lane>>4)&1)*32+(lane&3)*8+(4*hi+((lane&15)>>2))*64;
  const char*Kbase=shm+LDS_K; bf16x8 kf[8];
  const lds_cptr shm3=(lds_cptr)shm; const lds_cptr kp0=shm3+LDS_K+hi*1024+r32*16; const lds_cptr vp0=shm3+LDS_V+((lane>>4)&1)*32+(lane&3)*8+(4*hi+((lane&15)>>2))*64;
  const int NT=NKEYS/KVBLK;
  DMA_K(0,0);DMA_V(0,0);DMA_K(1,SLOTB);
  bf16x8 qr[4];
  #pragma unroll
  for(int d0=0;d0<4;++d0)qr[d0]=*reinterpret_cast<const bf16x8*>(&Qw[(long)r32*DM+d0*16+hi*8]);
  float mhat=0.f,l_reg=0.f;f32x16 o[2];o[0]=f32x16{};o[1]=f32x16{};f32x16 negm=f32x16{};asm volatile("":"+v"(negm));
  #define CMASK(P0,P1,t) do{}while(0)
  bool resc=false;
  #define START(P0,P1) do{ const float rm=rowmax(P0,P1); resc=false; \
    { const float dl=rm; mhat=fadd_s(mhat,dl); \
      _Pragma("unroll") for(int r=0;r<16;++r){P0[r]=fsub_s(P0[r],dl);P1[r]=fsub_s(P1[r],dl);} \
      _Pragma("unroll") for(int r=0;r<16;++r)negm[r]=-mhat; asm volatile("":"+v"(negm)); } \
    _Pragma("unroll") for(int r=0;r<16;++r)P0[r]=__builtin_amdgcn_exp2f(P0[r]); }while(0)
  #define RESC() do{ if(resc){ asm volatile("s_waitcnt lgkmcnt(0)":::"memory"); \
      _Pragma("unroll") for(int d_=0;d_<2;++d_) _Pragma("unroll") for(int r=0;r<16;++r)o[d_][r]*=wsf[crow(r,hi)]; } }while(0)
  f32x16 pA0,pA1,pB0,pB1;
  int sl_prev=0,sl_cur=0,sl_next=SLOTB;
  #define ROT() do{sl_prev=sl_cur;sl_cur=sl_next;sl_next=(sl_next==(NSLOT-1)*SLOTB)?0:sl_next+SLOTB;}while(0)
  DMA_K(2,2*SLOTB);
  WAIT_BAR(3);
  qkt(pA0,pA1,Kbase,qr,negm,r32,hi);asm volatile("s_nop 15\n\ts_nop 7":"+v"(pA0),"+v"(pA1));CMASK(pA0,pA1,0);
  START(pA0,pA1);
  _Pragma("unroll") for(int r=0;r<16;++r)pA1[r]=__builtin_amdgcn_exp2f(pA1[r]);
  WAIT_BAR(0);
  DMA_K(3,0);DMA_V(1,SLOTB);
  ROT();
  kload8(kf,kp0+sl_cur);
  WAIT_BAR(2);
  s16x4 vlo[8],vhi[8]; u32x4 pw0,pw1,pw2,pw3;
  #define PKW(P,B) cvtpk_s(P[B],P[B+1])
  #define PAF(k) __builtin_bit_cast(bf16x8,pw##k)
  #define VFR(i) (bf16x8){vlo[i][0],vlo[i][1],vlo[i][2],vlo[i][3],vhi[i][0],vhi[i][1],vhi[i][2],vhi[i][3]}
  #define PIN(x) asm volatile("":"+v"(x))
  #define MX3(a,b,c) __builtin_fmaxf(__builtin_fmaxf((a),(b)),(c))
  #define GAPA(MF,A0,A1,A2,A3,W0,W1,PW) do{ MF; sacc+=A0; sacc+=A1; sacc+=A2; sacc+=A3; PIN(sacc); W0; W1; PIN(PW); SBAR(); }while(0)
  #define EX(v) __builtin_amdgcn_exp2f(v)
  #define GAPB(MF,X,B) do{ MF; X[B]=EX(X[B]); X[B+1]=EX(X[B+1]); X[B+2]=EX(X[B+2]); X[B+3]=EX(X[B+3]); PIN(X); SBAR(); }while(0)
  #define VRD(i) do{ vlo[i]=vtr(vp_+(((i)>>2)*4096+((i)&3)*1024)); vhi[i]=vtr(vp_+(((i)>>2)*4096+((i)&3)*1024+512)); }while(0)
  #define KRD(G,j) do{ if(G){ kload2(kf,kp0+sl_next,j); SBAR(); } }while(0)
  #define STEP(C0,C1,P0,P1,t,GK,GV,GL) do{ SBAR(); \
    const lds_cptr vp_=vp0+sl_prev; \
    VRD(0); SBAR(); float sacc=(P0[0]+P0[1]); \
    GAPA(C0=__builtin_amdgcn_mfma_f32_32x32x16_bf16(kf[0],qr[0],negm,0,0,0), P0[2],P0[3],P0[4],P0[5],     pw0[0]=PKW(P0,0), pw0[1]=PKW(P0,2), pw0); \
    VRD(4); SBAR(); GAPA(C1=__builtin_amdgcn_mfma_f32_32x32x16_bf16(kf[1],qr[0],negm,0,0,0), P0[6],P0[7],P0[8],P0[9],     pw0[2]=PKW(P0,4), pw0[3]=PKW(P0,6), pw0); \
    VRD(1); SBAR(); GAPA(C0=__builtin_amdgcn_mfma_f32_32x32x16_bf16(kf[2],qr[1],C0,0,0,0),   P0[10],P0[11],P0[12],P0[13], pw1[0]=PKW(P0,8), pw1[1]=PKW(P0,10), pw1); \
    VRD(5); SBAR(); GAPA(C1=__builtin_amdgcn_mfma_f32_32x32x16_bf16(kf[3],qr[1],C1,0,0,0),   P0[14],P0[15],P1[0],P1[1],   pw1[2]=PKW(P0,12),pw1[3]=PKW(P0,14), pw1); \
    VRD(2); SBAR(); GAPA(C0=__builtin_amdgcn_mfma_f32_32x32x16_bf16(kf[4],qr[2],C0,0,0,0),   P1[2],P1[3],P1[4],P1[5],     pw2[0]=PKW(P1,0), pw2[1]=PKW(P1,2), pw2); \
    VRD(6); SBAR(); GAPA(C1=__builtin_amdgcn_mfma_f32_32x32x16_bf16(kf[5],qr[2],C1,0,0,0),   P1[6],P1[7],P1[8],P1[9],     pw2[2]=PKW(P1,4), pw2[3]=PKW(P1,6), pw2); \
    VRD(3); SBAR(); GAPA(C0=__builtin_amdgcn_mfma_f32_32x32x16_bf16(kf[6],qr[3],C0,0,0,0),   P1[10],P1[11],P1[12],P1[13], pw3[0]=PKW(P1,8), pw3[1]=PKW(P1,10), pw3); \
    VRD(7); SBAR(); GAPA(C1=__builtin_amdgcn_mfma_f32_32x32x16_bf16(kf[7],qr[3],C1,0,0,0),   P1[14],P1[15],0.f,0.f,       pw3[2]=PKW(P1,12),pw3[3]=PKW(P1,14), pw3); \
    l_reg+=sacc; \
    if(GK){DMA_K((t)+3,sl_cur);} if(GV){DMA_V((t)+1,sl_next);} \
    CMASK(C0,C1,t); \
    { float a=MX3(C0[0],C0[1],C1[0]),b=MX3(C0[2],C0[3],C1[1]); a=MX3(a,C1[2],C1[3]); \
      _Pragma("unroll") for(int r=4;r<16;r+=4){a=MX3(a,C0[r],C0[r+1]);b=MX3(b,C0[r+2],C0[r+3]);a=MX3(a,C1[r],C1[r+1]);b=MX3(b,C1[r+2],C1[r+3]);} \
      float rm=__builtin_fmaxf(a,b); { auto rr=__builtin_amdgcn_permlane32_swap(__float_as_uint(rm),__float_as_uint(rm),false,false); rm=__builtin_fmaxf(__uint_as_float(rr[0]),__uint_as_float(rr[1])); } \
      resc=false; \
      if(__builtin_expect(__any(rm>(float)THRL),0)){ const float dl=__builtin_fmaxf(rm,0.f); mhat+=dl; \
        _Pragma("unroll") for(int r=0;r<16;++r){C0[r]-=dl;C1[r]-=dl;} \
        _Pragma("unroll") for(int r=0;r<16;++r)negm[r]=-mhat; asm volatile("":"+v"(negm)); \
        const float f=__builtin_amdgcn_exp2f(-dl); l_reg*=f; if(hi==0)wsf[r32]=f; resc=true; } } \
    SBAR(); \
    GAPB(o[0]=__builtin_amdgcn_mfma_f32_32x32x16_bf16(PAF(0),VFR(0),o[0],0,0,0), C0,0); \
    GAPB(o[1]=__builtin_amdgcn_mfma_f32_32x32x16_bf16(PAF(0),VFR(4),o[1],0,0,0), C0,4); \
    KRD(GL,0); GAPB(o[0]=__builtin_amdgcn_mfma_f32_32x32x16_bf16(PAF(1),VFR(1),o[0],0,0,0), C0,8); \
    KRD(GL,1); GAPB(o[1]=__builtin_amdgcn_mfma_f32_32x32x16_bf16(PAF(1),VFR(5),o[1],0,0,0), C0,12); \
    KRD(GL,2); GAPB(o[0]=__builtin_amdgcn_mfma_f32_32x32x16_bf16(PAF(2),VFR(2),o[0],0,0,0), C1,0); \
    KRD(GL,3); GAPB(o[1]=__builtin_amdgcn_mfma_f32_32x32x16_bf16(PAF(2),VFR(6),o[1],0,0,0), C1,4); \
    GAPB(o[0]=__builtin_amdgcn_mfma_f32_32x32x16_bf16(PAF(3),VFR(3),o[0],0,0,0), C1,8); \
    GAPB(o[1]=__builtin_amdgcn_mfma_f32_32x32x16_bf16(PAF(3),VFR(7),o[1],0,0,0), C1,12); \
    }while(0)
  int t=1;
  for(;t+5<NT;t+=2){
    STEP(pB0,pB1,pA0,pA1,t,true,true,true);     WAIT_BAR(2); RESC(); ROT();
    STEP(pA0,pA1,pB0,pB1,t+1,true,true,true);   WAIT_BAR(2); RESC(); ROT();
  }
  #define ENDW(tt) do{ if((tt)+3<NT){WAIT_BAR(2);} else if((tt)+2<NT){WAIT_BAR(1);} else {WAIT_BAR(0);} }while(0)
  for(;t+1<NT;t+=2){
    STEP(pB0,pB1,pA0,pA1,t,(t+3<NT),(t+1<NT),(t+1<NT));       ENDW(t);   RESC(); ROT();
    STEP(pA0,pA1,pB0,pB1,t+1,(t+4<NT),(t+2<NT),(t+2<NT));     ENDW(t+1); RESC(); ROT();
  }
  STEP(pB0,pB1,pA0,pA1,NT-1,false,false,false); RESC();
  { float sacc=pB0[0]+pB0[1]; _Pragma("unroll") for(int r=2;r<16;++r)sacc+=pB0[r]; _Pragma("unroll") for(int r=0;r<16;++r)sacc+=pB1[r]; l_reg+=sacc;
    pw0=(u32x4){PKW(pB0,0),PKW(pB0,2),PKW(pB0,4),PKW(pB0,6)};pw1=(u32x4){PKW(pB0,8),PKW(pB0,10),PKW(pB0,12),PKW(pB0,14)};pw2=(u32x4){PKW(pB1,0),PKW(pB1,2),PKW(pB1,4),PKW(pB1,6)};pw3=(u32x4){PKW(pB1,8),PKW(pB1,10),PKW(pB1,12),PKW(pB1,14)};
    SBAR(); pv(o,vb0+sl_cur,PAF(0),PAF(1),PAF(2),PAF(3)); }
  #undef PKW
  #undef PAF
  #undef VFR
  #undef PIN
  #undef MX3
  #undef GAPA
  #undef GAPB
  #undef EX
  #undef VRD
  #undef KRD
  #undef STEP
  #undef ENDW
  {auto rr=__builtin_amdgcn_permlane32_swap(__float_as_uint(l_reg),__float_as_uint(l_reg),false,false);l_reg=__uint_as_float(rr[0])+__uint_as_float(rr[1]);}
  if(hi==0)wsf[32+r32]=l_reg;asm volatile("s_waitcnt lgkmcnt(0)":::"memory");
  float rli[16];
  #pragma unroll
  for(int r=0;r<16;++r)rli[r]=__builtin_amdgcn_rcpf(wsf[32+crow(r,hi)]);
  bf16*Ow=Ob+(long)(wid*QBLK)*opitch;
  { bf16*stg=(bf16*)(shm+LDS_OST)+wid*2048;
    #pragma unroll
    for(int r=0;r<16;++r){const int orow=crow(r,hi);
      #pragma unroll
      for(int d0=0;d0<2;++d0)stg[orow*64+d0*32+r32]=__float2bfloat16(o[d0][r]*rli[r]);}
    asm volatile("s_waitcnt lgkmcnt(0)":::"memory");
    #pragma unroll
    for(int i=0;i<4;++i){const int row=i*8+(lane>>3),ch=lane&7; const u32x4 v=*(const u32x4*)(stg+row*64+ch*8); ATTN_STORE16(Ow+(long)row*opitch+ch*8,v);} }
  asm volatile("s_waitcnt lgkmcnt(0)\n\ts_barrier":::"memory");
  #undef DMA_K
  #undef DMA_V
  #undef CMASK
  #undef START
  #undef RESC
  #undef ROT
}
constexpr int ATTN_LDS_BYTES=LDS_BYTES;
#undef SBAR
#undef WAIT_BAR
}
namespace cg = cooperative_groups;
#define LAS __attribute__((address_space(3)))
typedef unsigned short u16;
typedef unsigned v4u __attribute__((ext_vector_type(4)));
typedef unsigned v2u __attribute__((ext_vector_type(2)));
typedef float f32x4 __attribute__((ext_vector_type(4)));
#define LDS_WAIT() asm volatile("s_waitcnt lgkmcnt(0)" ::: "memory")
#define VM_WAIT() asm volatile("s_waitcnt vmcnt(0)" ::: "memory")
__device__ __forceinline__ unsigned f2bf(float f) { unsigned u = __builtin_bit_cast(unsigned, f); return (u + 0x7fffu + ((u >> 16) & 1u)) >> 16; }
__device__ __forceinline__ unsigned pk2(float lo, float hi) { return f2bf(lo) | (f2bf(hi) << 16); }
__device__ __forceinline__ float bflo(unsigned w) { return __uint_as_float(w << 16); }
__device__ __forceinline__ float bfhi(unsigned w) { return __uint_as_float(w & 0xffff0000u); }
__device__ __forceinline__ float wave_sum(float v) {
#pragma unroll
    for (int o = 1; o < 64; o <<= 1) v += __shfl_xor(v, o);
    return v;
}

#define XB_TMO      128
#define XB_XCNT(j)  (256  + 64 * (j))
#define XB_XSUB(j)  (1280 + 64 * (j))
#define XB_XGEN(j)  (2304 + 64 * (j))
#define XB_TOP      3328
#define XB_TOPGEN   3392
#define XCD_BAR_WORDS 3456
#define XB_SPIN_CAP (1u << 18)

__device__ __forceinline__ unsigned xb_ld(unsigned* p)              { return __hip_atomic_load(p, __ATOMIC_RELAXED, __HIP_MEMORY_SCOPE_AGENT); }
__device__ __forceinline__ unsigned xb_add(unsigned* p, unsigned v) { return __hip_atomic_fetch_add(p, v, __ATOMIC_RELAXED, __HIP_MEMORY_SCOPE_AGENT); }
__device__ __forceinline__ unsigned xb_xcc_id() { return (unsigned)__builtin_amdgcn_s_getreg((3 << 11) | 20) & 0xFu; }
#define XB_SPIN(cond, bar) do { unsigned _sp = 0; while (cond) { __builtin_amdgcn_s_sleep(1); \
    if ((++_sp & 255u) == 0u) { if (xb_ld(&(bar)[XB_TMO])) break; if (_sp > XB_SPIN_CAP) { atomicAdd(&(bar)[XB_TMO], 1u); break; } } } } while (0)

struct XcdBarrier {
    unsigned* bar; unsigned x;
    volatile LAS unsigned* st;
};

__device__ __forceinline__ XcdBarrier xcd_barrier_post(unsigned* bar, volatile LAS unsigned* st) {
    XcdBarrier b; b.bar = bar; b.x = xb_xcc_id(); b.st = st;
    if (threadIdx.x == 0) (void)xb_add(&bar[XB_XCNT(b.x)], 1u);
    return b;
}
__device__ __forceinline__ void xcd_barrier_complete(unsigned* bar, unsigned x, unsigned& nloc, unsigned& nx) {
    const unsigned G = gridDim.x * gridDim.y * gridDim.z;
    unsigned sum, cnt, mine, sp = 0u;
    for (;;) {
        sum = 0u; cnt = 0u; mine = 0u;
#pragma unroll
        for (unsigned j = 0; j < 16; ++j) { const unsigned c = xb_ld(&bar[XB_XCNT(j)]); sum += c; cnt += (c > 0u) ? 1u : 0u; mine = (j == x) ? c : mine; }
        if (sum == G) break;
        __builtin_amdgcn_s_sleep(1);
        if ((++sp & 255u) == 0u) { if (xb_ld(&bar[XB_TMO])) break; if (sp > XB_SPIN_CAP) { atomicAdd(&bar[XB_TMO], 1u); break; } }
    }
    nloc = mine > 0u ? mine : 1u; nx = cnt > 0u ? cnt : 1u;
}

__device__ __forceinline__ void xcd_barrier(const XcdBarrier& b) {
    asm volatile("s_waitcnt vmcnt(0)" ::: "memory");
    __syncthreads();
    if (threadIdx.x == 0) {
        unsigned* bar = b.bar;
        __builtin_amdgcn_s_waitcnt(0);
        unsigned nloc = b.st[0], nx = b.st[1];
        if (nloc == 0u) { xcd_barrier_complete(bar, b.x, nloc, nx); b.st[0] = nloc; b.st[1] = nx; }
        const unsigned old = xb_add(&bar[XB_XSUB(b.x)], 1u);
        const unsigned gen = old / nloc;
        if (old + 1u == (gen + 1u) * nloc) {
            __builtin_amdgcn_fence(__ATOMIC_RELEASE, "agent");
            asm volatile("s_waitcnt vmcnt(0)" ::: "memory");
            const unsigned og = xb_add(&bar[XB_TOP], 1u);
            const unsigned tg = og / nx;
            if (og + 1u == (tg + 1u) * nx) xb_add(&bar[XB_TOPGEN], 1u);
            else XB_SPIN(xb_ld(&bar[XB_TOPGEN]) == tg, bar);
            __builtin_amdgcn_fence(__ATOMIC_ACQUIRE, "agent");
            xb_add(&bar[XB_XGEN(b.x)], 1u);
            asm volatile("s_waitcnt vmcnt(0)" ::: "memory");
        } else {
            XB_SPIN(xb_ld(&bar[XB_XGEN(b.x)]) == gen, bar);
            __builtin_amdgcn_fence(__ATOMIC_ACQUIRE, "agent");
            asm volatile("s_waitcnt vmcnt(0)" ::: "memory");
        }
    }
    __syncthreads();
}


constexpr int NWAVES = 8, NTHREADS = 512;
constexpr int DM = 1024, NB = 8, SEQ = 2048, CTXL = 256, MTOK = NB * SEQ, RPB = CTXL + SEQ  , MST = NB * RPB, INW = 2304, DFF = 2816, NMOD = 6 * DM;
constexpr int OFF_AQ = 0, OFF_AK = 512, OFF_AV = 1024, OFF_BQ = 1536, OFF_BK = 2048, OFF_BV = 2176;
constexpr float EPS = 1e-6f;
constexpr size_t MiB = 1u << 20;
constexpr size_t WS_MODS = 1 * MiB, WS_ZERO_BYTES = 2 * MiB;
constexpr size_t WS_ROPEC = 2 * MiB, WS_ROPES = WS_ROPEC + 4096, WS_CS128 = 2 * MiB + 65536;
constexpr size_t WS_WIN = 3 * MiB, WS_WO0 = 8 * MiB, WS_GU0 = 10 * MiB, WS_DN0 = 21 * MiB, WS_WO1 = 27 * MiB, WS_GU1 = 29 * MiB, WS_DN1 = 40 * MiB, WS_WCS = 46 * MiB;
constexpr size_t WS_HC = 62 * MiB, WS_BIG = 98 * MiB, WS_ATT = 186 * MiB, WS_TMP = 218 * MiB, WS_END = 250 * MiB;
constexpr int LDS_BYTES = 147456, LUT_OFF = 131072, MISC_OFF = 131072 + 8192;
constexpr size_t WS_BAR = 4096;
constexpr int NPHASE = 17;

struct Args { const float* in[27]; float* out; unsigned char* ws; int ph_lo, ph_hi; };

__device__ __forceinline__ void p0_transpose_item(const float* W, int K, int N, u16* WT, int mode, int item, int lane) {
    const int nblk = N / 256, kb = item / nblk, nb = item - kb * nblk, k0 = 32 * kb, n0 = 256 * nb + 4 * lane;
    const float* src = W + (size_t)k0 * N + n0;
    f32x4 v[32];
#pragma unroll
    for (int k = 0; k < 32; ++k) v[k] = *(const f32x4*)(src + (size_t)k * N);
#pragma unroll
    for (int e = 0; e < 4; ++e) { const int n = n0 + e; int d = n;
        if (mode == 1) { const int up = n >= DFF, j = up ? n - DFF : n; d = (j >> 7) * 256 + up * 128 + (j & 127); }
        u16* dp = WT + (size_t)d * K + k0;
#pragma unroll
        for (int q = 0; q < 4; ++q) { v4u o; o.x = pk2(v[8 * q][e], v[8 * q + 1][e]); o.y = pk2(v[8 * q + 2][e], v[8 * q + 3][e]); o.z = pk2(v[8 * q + 4][e], v[8 * q + 5][e]); o.w = pk2(v[8 * q + 6][e], v[8 * q + 7][e]);
            *(v4u*)(dp + 8 * q) = o; } }
}

__device__ __forceinline__ const float* norm_src(const float* x, const float* ctx, bool stacked, int R, int& key) {
    if (stacked) { const int b = R / RPB, r = R - b * RPB;
        if (r < CTXL) { key = 8; return ctx + (size_t)(b * CTXL + r) * DM; } key = b; return x + (size_t)(b * SEQ + r - CTXL) * DM; }
    key = R >> 11; return x + (size_t)R * DM;
}
__device__ __forceinline__ void norm_rows(const float* x, const float* ctx, bool stacked, u16* dst, const float* g, const float* mods, int shift_off, int scale_off, int gw, int NGW, int lane) {
    const int nrows = stacked ? MST : MTOK, rpw = (nrows + NGW - 1) / NGW;
    const int R0 = gw * rpw, R1 = (R0 + rpw < nrows) ? R0 + rpw : nrows;
    if (R0 >= R1) return;
    f32x4 gs[4], sh[4]; int curkey = -1, key;
    const float* src = norm_src(x, ctx, stacked, R0, key);
    f32x4 v[4], nv[4];
#pragma unroll
    for (int j = 0; j < 4; ++j) v[j] = ((const f32x4*)src)[64 * j + lane];
    for (int R = R0; R < R1; ++R) {
        int nkey = key;
        if (R + 1 < R1) { const float* nsrc = norm_src(x, ctx, stacked, R + 1, nkey);
#pragma unroll
            for (int j = 0; j < 4; ++j) nv[j] = ((const f32x4*)nsrc)[64 * j + lane]; }
        if (key != curkey) { curkey = key; const float* mrow = mods + (size_t)key * NMOD;
#pragma unroll
            for (int j = 0; j < 4; ++j) { gs[j] = ((const f32x4*)g)[64 * j + lane] * (((const f32x4*)(mrow + scale_off))[64 * j + lane] + 1.0f); sh[j] = ((const f32x4*)(mrow + shift_off))[64 * j + lane]; } }
        float s = 0.f;
#pragma unroll
        for (int j = 0; j < 4; ++j) s += (v[j].x * v[j].x + v[j].y * v[j].y) + (v[j].z * v[j].z + v[j].w * v[j].w);
        const float rstd = 1.0f / sqrtf(wave_sum(s) * (1.0f / DM) + EPS);
        unsigned long long* o8 = (unsigned long long*)(dst + (size_t)R * DM) + lane;
#pragma unroll
        for (int j = 0; j < 4; ++j) { const f32x4 y = v[j] * rstd * gs[j] + sh[j];
            o8[64 * j] = (unsigned long long)pk2(y.x, y.y) | ((unsigned long long)pk2(y.z, y.w) << 32); }
#pragma unroll
        for (int j = 0; j < 4; ++j) v[j] = nv[j];
        key = nkey;
    }
}

__global__ void __launch_bounds__(NTHREADS, 2) mega_fwd(Args args) {
    extern __shared__ __attribute__((aligned(16))) unsigned char lds[];
    LAS unsigned char* L = (LAS unsigned char*)lds;
    const int tid = threadIdx.x, lane = tid & 63, wave = __builtin_amdgcn_readfirstlane(tid >> 6);
    const int G = gridDim.x, bx = blockIdx.x;
    const int vcu = (G % 8 == 0) ? (bx % 8) * (G / 8) + bx / 8 : bx;
    const int gw = vcu * NWAVES + wave, NGW = G * NWAVES;
    unsigned char* ws = args.ws;
    const float* x_in = args.in[0]; float* out = args.out;
    float* mods = (float*)(ws + WS_MODS);
    u16* HC = (u16*)(ws + WS_HC); u16* BIG = (u16*)(ws + WS_BIG); u16* ATT = (u16*)(ws + WS_ATT); u16* TMP = (u16*)(ws + WS_TMP);
    const int lo = args.ph_lo, hi = args.ph_hi;
    volatile LAS unsigned* MISC = (volatile LAS unsigned*)(L + MISC_OFF);
    if (tid < 2) MISC[tid] = 0u;
    __syncthreads();
    XcdBarrier bar = xcd_barrier_post((unsigned*)(ws + WS_BAR), MISC);
#ifndef PHMASK
#define PHMASK 0x1ffff
#endif
#define IN(k) (((PHMASK >> (k)) & 1) && lo <= (k) && (k) < hi)
#ifndef REPMASK
#define REPMASK 0
#endif
#ifndef TS_SEL
#define TS_SEL -1
#endif
#ifndef TS_DIV
#define TS_DIV 2000.0f
#endif
#define PH(k) if (IN(k) && ((TS_SEL < 0) || ((bx == 0 && tid == 0) ? (((unsigned long long*)(ws + 8192))[k] = __builtin_amdgcn_s_memrealtime(), true) : true)))
#define SEAM(k) do { if (IN((k) + 1)) { if ((k) == 0) cg::this_grid().sync(); else xcd_barrier(bar); } } while (0)

    PH(0) {
        LAS float* lut = (LAS float*)(L + LUT_OFF);
        for (int m = tid; m < 2048; m += NTHREADS) lut[m] = cospif((float)m * (1.0f / 1024.0f));
        __syncthreads();
        for (int it = bx; it < 48; it += G) {
            const int l = it / 24, nc = it % 24; const float* W = args.in[l ? 19 : 4]; const float* bias = args.in[l ? 20 : 5];
            LAS float* sv = (LAS float*)(L + wave * 16384);
            const int k0 = wave * 128;
#pragma unroll
            for (int bb = 0; bb < 9; ++bb)
#pragma unroll
                for (int h = 0; h < 2; ++h) { const int k = k0 + h * 64 + lane; const float v = bb < 8 ? args.in[1][bb * DM + k] : args.in[3][k]; sv[bb * 128 + h * 64 + lane] = v / (1.0f + __expf(-v)); }
            LDS_WAIT(); asm volatile("" ::: "memory");
            f32x4 acc[9];
#pragma unroll
            for (int bb = 0; bb < 9; ++bb) acc[bb] = (f32x4){0.f, 0.f, 0.f, 0.f};
            const float* wp = W + (size_t)k0 * NMOD + nc * 256 + 4 * lane;
#pragma unroll 16
            for (int kk = 0; kk < 128; ++kk) { const f32x4 w = *(const f32x4*)(wp + (size_t)kk * NMOD);
#pragma unroll
                for (int bb = 0; bb < 9; ++bb) acc[bb] += w * sv[bb * 128 + kk]; }
            LDS_WAIT(); asm volatile("" ::: "memory");
            LAS f32x4* red = (LAS f32x4*)(L + wave * 16384);
#pragma unroll
            for (int bb = 0; bb < 9; ++bb) red[bb * 64 + lane] = acc[bb];
            __syncthreads();
            for (int o = tid; o < 9 * 64; o += NTHREADS) { f32x4 s = (f32x4){0.f, 0.f, 0.f, 0.f};
#pragma unroll
                for (int w8 = 0; w8 < 8; ++w8) s += ((LAS f32x4*)(L + w8 * 16384))[o];
                const int bb = o >> 6, ln = o & 63; s += *(const f32x4*)(bias + nc * 256 + 4 * ln);
                *(f32x4*)(mods + (size_t)(l * 9 + bb) * NMOD + nc * 256 + 4 * ln) = s; }
            __syncthreads();
        }
        {
            constexpr int I_IN = 32 * 9, I_O = 32 * 4, I_GU = 32 * 22, I_DN = 88 * 4;
            constexpr int NIT = I_IN + 2 * (I_O + I_GU + I_DN);
            for (int it = gw; it < NIT; it += NGW) {
                int r = it;
                if (r < I_IN) { p0_transpose_item(args.in[7], DM, INW, (u16*)(ws + WS_WIN), 0, r, lane); continue; } r -= I_IN;
                if (r < I_O) { p0_transpose_item(args.in[15], DM, DM, (u16*)(ws + WS_WO0), 0, r, lane); continue; } r -= I_O;
                if (r < I_GU) { p0_transpose_item(args.in[17], DM, 2 * DFF, (u16*)(ws + WS_GU0), 1, r, lane); continue; } r -= I_GU;
                if (r < I_DN) { p0_transpose_item(args.in[18], DFF, DM, (u16*)(ws + WS_DN0), 0, r, lane); continue; } r -= I_DN;
                if (r < I_O) { p0_transpose_item(args.in[22], DM, DM, (u16*)(ws + WS_WO1), 0, r, lane); continue; } r -= I_O;
                if (r < I_GU) { p0_transpose_item(args.in[24], DM, 2 * DFF, (u16*)(ws + WS_GU1), 1, r, lane); continue; } r -= I_GU;
                p0_transpose_item(args.in[25], DFF, DM, (u16*)(ws + WS_DN1), 0, r, lane);
            }
        }
        for (int r = gw; r < 2048; r += NGW) {
            u16* row = (u16*)(ws + WS_WCS) + (size_t)r * 2048; const int k = r & 1023, ph = (r >= 1024) ? 512 : 0;
#pragma unroll 2
            for (int i = 0; i < 4; ++i) { const int n0 = (i * 64 + lane) * 8; float v[8];
#pragma unroll
                for (int e = 0; e < 8; ++e) v[e] = lut[(k * (n0 + e) - ph) & 2047];
                v4u o; o.x = pk2(v[0], v[1]); o.y = pk2(v[2], v[3]); o.z = pk2(v[4], v[5]); o.w = pk2(v[6], v[7]);
                *(v4u*)(row + n0) = o; }
        }
        for (int i = gw * 64 + lane; i < 256 * 128; i += NGW * 64) { const int r = i >> 7, j = i & 127, cs = r >> 7, jp = r & 127, m = ((jp * j) & 127) * 16;
            ((u16*)(ws + WS_CS128))[i] = (u16)f2bf(cs ? lut[(m - 512) & 2047] : lut[m]); }
        for (int i = gw * 64 + lane; i < 1024; i += NGW * 64) { const int pos = i >> 4, p = i & 15; const float inv = powf(10000.0f, -(float)p / 16.0f), ang = (float)pos * inv;
            ((float*)(ws + WS_ROPEC))[i] = cosf(ang); ((float*)(ws + WS_ROPES))[i] = sinf(ang); }
        SEAM(0);
    }
    PH(1) { norm_rows(x_in, args.in[2], true, HC, args.in[6], mods, 0 * DM, 1 * DM, gw, NGW, lane); SEAM(1); }
    PH(2) {
        pg8::GemmStd g{HC, (const u16*)(ws + WS_WIN), DM, DM, DM}; pg8::StaticOrder S; S.init(MST, INW, G, bx);
        pg8::EpiBf16 E{BIG, INW};
        pg8::gemm_phase<pg8::EpiBf16, pg8::GemmStd, pg8::StaticOrder, true, true>(L, g, S, E);
        SEAM(2);
    }
    PH(3) {
        const float* ropeC = (const float*)(ws + WS_ROPEC); const float* ropeS = (const float*)(ws + WS_ROPES);
        const int sub = lane & 7, hs = lane >> 3, axis = sub >> 2, q4 = sub & 3, dcol = axis * 32 + 4 * q4;
        const f32x4 gq1 = *(const f32x4*)(args.in[13] + dcol), gq2 = *(const f32x4*)(args.in[13] + dcol + 16);
        const f32x4 gk1 = *(const f32x4*)(args.in[14] + dcol), gk2 = *(const f32x4*)(args.in[14] + dcol + 16);
        constexpr float C2 = 0.125f * 1.4426950408889634f;
        for (int R = gw; R < MST; R += NGW) {
            const int b = R / RPB, r = R - b * RPB; const bool isctx = r < CTXL; const int s = r - CTXL;
            const int pos = axis ? (s & 63) : (s >> 6);
            f32x4 cs = (f32x4){1.f, 1.f, 1.f, 1.f}, sn = (f32x4){0.f, 0.f, 0.f, 0.f};
            if (!isctx) { cs = *(const f32x4*)(ropeC + pos * 16 + 4 * q4); sn = *(const f32x4*)(ropeS + pos * 16 + 4 * q4); }
            u16* row = BIG + (size_t)R * INW;
#pragma unroll
            for (int it = 0; it < 4; ++it) {
                if (isctx && it != 3) continue;
                const bool act = (it != 3) || (hs < 2);
                const int col = (it == 0 ? OFF_AQ : it == 1 ? OFF_AK : it == 2 ? OFF_BQ : OFF_BK) + (act ? hs : 0) * 64 + dcol;
                const v2u w1 = *(const v2u*)(row + col), w2 = *(const v2u*)(row + col + 16);
                f32x4 x1 = (f32x4){bflo(w1.x), bfhi(w1.x), bflo(w1.y), bfhi(w1.y)}, x2 = (f32x4){bflo(w2.x), bfhi(w2.x), bflo(w2.y), bfhi(w2.y)};
                if (it >= 2) { float ss = (x1.x * x1.x + x1.y * x1.y) + (x1.z * x1.z + x1.w * x1.w) + (x2.x * x2.x + x2.y * x2.y) + (x2.z * x2.z + x2.w * x2.w);
                    ss += __shfl_xor(ss, 1); ss += __shfl_xor(ss, 2); ss += __shfl_xor(ss, 4);
                    const float rstd = 1.0f / sqrtf(ss * (1.0f / 64.0f) + EPS);
                    x1 = x1 * rstd * (it == 2 ? gq1 : gk1); x2 = x2 * rstd * (it == 2 ? gq2 : gk2); }
                f32x4 o1 = x1 * cs - x2 * sn, o2 = x2 * cs + x1 * sn;
                if (it == 0 || it == 2) { o1 = o1 * C2; o2 = o2 * C2; }
                if (act) { v2u a, c; a.x = pk2(o1.x, o1.y); a.y = pk2(o1.z, o1.w); c.x = pk2(o2.x, o2.y); c.y = pk2(o2.z, o2.w);
                    *(v2u*)(row + col) = a; *(v2u*)(row + col + 16) = c; }
            }
        }
        SEAM(3);
    }
    PH(4) {
        typedef attn_body::bf16 abf;
        const abf* P = (const abf*)BIG;
        for (int s = vcu; s < 256; s += G) {
            const int b = s >> 5, i = s & 31;
            const abf* kvb = P + (size_t)b * RPB * INW;
            for (int r = 0; r < 6; ++r) {
                const abf *Qb, *Kh, *Vh; abf* Ob; int qb;
                if (r < 4) { const int h = i >> 3, m = r >> 1, v = r & 1; qb = i & 7;
                    Qb = kvb + (size_t)(CTXL + qb * 256) * INW + OFF_AQ + h * 128 + m * 64; Kh = kvb + OFF_AK + h * 128 + m * 64; Vh = kvb + OFF_AV + h * 128 + v * 64;
                    Ob = (abf*)TMP + (size_t)(b * SEQ + qb * 256) * DM + h * 256 + m * 128 + v * 64; }
                else { const int u = 2 * i + (r - 4), hq = u >> 3; qb = u & 7;
                    Qb = kvb + (size_t)(CTXL + qb * 256) * INW + OFF_BQ + hq * 64; Kh = kvb + OFF_BK + (hq >> 2) * 64; Vh = kvb + OFF_BV + (hq >> 2) * 64;
                    Ob = (abf*)ATT + (size_t)(b * SEQ + qb * 256) * DM + 512 + hq * 64; }
#ifndef SKIP_ATTN
                attn_body::attn_unit<8>(Qb, Kh, Vh, Ob, (char*)lds);
#endif
            }
        }
        asm volatile("" ::: "memory");
        for (int s = vcu; s < 256; s += G) {
            const int b = s >> 5, i = s & 31, qb = i & 7;
            {
                    VM_WAIT();
                    const float lam = expf(wave_sum(args.in[8][lane] * args.in[9][lane])) - expf(wave_sum(args.in[10][lane] * args.in[11][lane])) + 0.2f;
                    const int h = i >> 3, half = lane >> 5, l32 = lane & 31;
                    const f32x4 sg = *(const f32x4*)(args.in[12] + 4 * l32);
                    const size_t row0 = (size_t)(b * SEQ + qb * 256 + wave * 32);
                    for (int rr = 0; rr < 16; ++rr) { const size_t row = row0 + 2 * rr + half;
                        const unsigned long long* t1 = (const unsigned long long*)(TMP + row * DM + h * 256) + l32;
                        const unsigned long long a = __hip_atomic_load(t1, __ATOMIC_RELAXED, __HIP_MEMORY_SCOPE_AGENT), c = __hip_atomic_load(t1 + 32, __ATOMIC_RELAXED, __HIP_MEMORY_SCOPE_AGENT);
                        const unsigned a0 = (unsigned)a, a1 = (unsigned)(a >> 32), c0 = (unsigned)c, c1 = (unsigned)(c >> 32);
                        f32x4 d = (f32x4){bflo(a0) - lam * bflo(c0), bfhi(a0) - lam * bfhi(c0), bflo(a1) - lam * bflo(c1), bfhi(a1) - lam * bfhi(c1)};
                        float ss = (d.x * d.x + d.y * d.y) + (d.z * d.z + d.w * d.w);
                        ss += __shfl_xor(ss, 1); ss += __shfl_xor(ss, 2); ss += __shfl_xor(ss, 4); ss += __shfl_xor(ss, 8); ss += __shfl_xor(ss, 16);
                        const float rstd = 0.8f / sqrtf(ss * (1.0f / 128.0f) + EPS);
                        d = d * rstd * sg;
                        *(unsigned long long*)(ATT + row * DM + h * 128 + 4 * l32) = (unsigned long long)pk2(d.x, d.y) | ((unsigned long long)pk2(d.z, d.w) << 32); }
            }
        }
        SEAM(4);
    }
    PH(5) {
        pg8::GemmStd g{ATT, (const u16*)(ws + WS_WO0), DM, DM, DM}; pg8::StaticOrder S; S.init(MTOK, DM, G, bx);
        pg8::EpiResGate E{x_in, out, mods + 2 * DM, NMOD};
        pg8::gemm_phase<pg8::EpiResGate, pg8::GemmStd, pg8::StaticOrder, true, true>(L, g, S, E);
        SEAM(5);
    }
    const float* ml0 = mods; const float* ml1 = mods + (size_t)9 * NMOD;
        PH(6) { norm_rows(out, nullptr, false, HC, args.in[16], ml0, 3 * DM, 4 * DM, gw, NGW, lane); SEAM(6); }
        PH(7) {
            pg8::GemmStd g{HC, (const u16*)(ws + (WS_GU0)), DM, DM, DM}; pg8::StaticOrder S; S.init(MTOK, 2 * DFF, G, bx);
            pg8::EpiSwiglu E{BIG, DFF};
            pg8::gemm_phase<pg8::EpiSwiglu, pg8::GemmStd, pg8::StaticOrder, true, true>(L, g, S, E);
            SEAM(7);
        }
        PH(8) {
            pg8::GemmStd g{BIG, (const u16*)(ws + (WS_DN0)), DFF, DFF, DFF}; pg8::StaticOrder S; S.init(MTOK, DM, G, bx);
            pg8::EpiResGate E{out, out, ml0 + 5 * DM, NMOD};
            pg8::gemm_phase<pg8::EpiResGate, pg8::GemmStd, pg8::StaticOrder, true, true>(L, g, S, E);
            SEAM(8);
        }
            PH(9) { norm_rows(out, nullptr, false, HC, args.in[21], ml1, 0 * DM, 1 * DM, gw, NGW, lane); SEAM(9); }
            PH(10) {
                int k128 = 128; asm volatile("" : "+s"(k128));
                pg8::GemmF1 g{(const u16*)(ws + WS_CS128), HC, k128, 128, DM}; pg8::StaticOrder S; S.init(MTOK, 2048, G, bx);
                pg8::EpiF1 E{BIG};
                pg8::gemm_phase<pg8::EpiF1, pg8::GemmF1, pg8::StaticOrder, true, true>(L, g, S, E);
                SEAM(10);
            }
            PH(11) {
                pg8::GemmF2 g{(const u16*)(ws + WS_WCS), BIG, 2048, 2048, 4096}; pg8::StaticOrder S; S.init(MTOK, DM, G, bx);
                pg8::EpiBf16 E{TMP, DM};
                pg8::gemm_phase<pg8::EpiBf16, pg8::GemmF2, pg8::StaticOrder, true, true>(L, g, S, E);
                xcd_barrier(bar);
                for (int R = gw; R < NB * 1024; R += NGW) { const int b = R >> 10, k = R & 1023;
                    const v4u* pp = (const v4u*)(TMP + ((size_t)(b * 2048 + k)) * DM) + lane; const v4u* qp = (const v4u*)(TMP + ((size_t)(b * 2048 + 1024 + k)) * DM) + lane;
                    v4u* f1 = (v4u*)(ATT + ((size_t)(b * SEQ + k)) * DM) + lane; v4u* f2 = (v4u*)(ATT + ((size_t)(b * SEQ + (k ? SEQ - k : 0))) * DM) + lane;
#pragma unroll
                    for (int j = 0; j < 2; ++j) { const v4u p = pp[64 * j], q = qp[64 * j]; v4u a, c;
#pragma unroll
                        for (int e = 0; e < 4; ++e) { const float pl = bflo(p[e]), ph = bfhi(p[e]), ql = bflo(q[e]), qh = bfhi(q[e]); a[e] = pk2(pl - ql, ph - qh); c[e] = pk2(pl + ql, ph + qh); }
                        f1[64 * j] = a; if (k) f2[64 * j] = c; }
                }
                for (int R = gw; R < NB * 1024; R += NGW) {
                    const v4u* yp = (const v4u*)(BIG + (size_t)R * 4096) + lane; float sacc = 0.f;
#pragma unroll
                    for (int j = 0; j < 4; ++j) { const v4u y = yp[64 * j];
#pragma unroll
                        for (int e = 0; e < 4; ++e) sacc += bflo(y[e]) - bfhi(y[e]); }
                    sacc = wave_sum(sacc);
                    if (lane == 0) ATT[((size_t)((R >> 10) * SEQ + 1024)) * DM + (R & 1023)] = (u16)f2bf(sacc);
                }
                SEAM(11);
            }
            PH(12) {
                pg8::GemmStd g{ATT, (const u16*)(ws + WS_WO1), DM, DM, DM}; pg8::StaticOrder S; S.init(MTOK, DM, G, bx);
                pg8::EpiResGate E{out, out, ml1 + 2 * DM, NMOD};
                pg8::gemm_phase<pg8::EpiResGate, pg8::GemmStd, pg8::StaticOrder, true, true>(L, g, S, E);
                SEAM(12);
            }
        PH(13) { norm_rows(out, nullptr, false, HC, args.in[23], ml1, 3 * DM, 4 * DM, gw, NGW, lane); SEAM(13); }
        PH(14) {
            pg8::GemmStd g{HC, (const u16*)(ws + (WS_GU1)), DM, DM, DM}; pg8::StaticOrder S; S.init(MTOK, 2 * DFF, G, bx);
            pg8::EpiSwiglu E{BIG, DFF};
            pg8::gemm_phase<pg8::EpiSwiglu, pg8::GemmStd, pg8::StaticOrder, true, true>(L, g, S, E);
            SEAM(14);
        }
        PH(15) {
            pg8::GemmStd g{BIG, (const u16*)(ws + (WS_DN1)), DFF, DFF, DFF}; pg8::StaticOrder S; S.init(MTOK, DM, G, bx);
            pg8::EpiResGate E{out, out, ml1 + 5 * DM, NMOD};
            pg8::gemm_phase<pg8::EpiResGate, pg8::GemmStd, pg8::StaticOrder, true, true>(L, g, S, E);
            SEAM(15);
        }
    PH(16) {
        const float* g = args.in[26];
        for (int R = gw; R < MTOK; R += NGW) {
            f32x4* xr = (f32x4*)(out + (size_t)R * DM) + lane; f32x4 v[4]; float s = 0.f;
#pragma unroll
            for (int j = 0; j < 4; ++j) { v[j] = xr[64 * j]; s += (v[j].x * v[j].x + v[j].y * v[j].y) + (v[j].z * v[j].z + v[j].w * v[j].w); }
            const float rstd = 1.0f / sqrtf(wave_sum(s) * (1.0f / DM) + EPS);
#pragma unroll
            for (int j = 0; j < 4; ++j) xr[64 * j] = v[j] * rstd * ((const f32x4*)g)[64 * j + lane];
#if TS_SEL >= 0
            if (R == 0 && lane == 0) { const unsigned long long* ts = (const unsigned long long*)(ws + 8192); out[0] += (float)(ts[TS_SEL + 1] - ts[TS_SEL]) * (0.01f / TS_DIV); }
#endif
        }
    }
#undef IN
#undef SEAM
}

#ifndef MK_MULTI
#define MK_MULTI (REPMASK != 0)
#endif
extern "C" void kernel_launch(void* const* d_in, const int* in_sizes, int n_in, void* d_out, int out_size, void* d_ws, size_t ws_size, hipStream_t stream) {
    static int grid = 0;
    if (grid == 0) {
        if (n_in != 27 || out_size != MTOK * DM || ws_size < WS_END) { fprintf(stderr, "kernel_launch: unexpected shapes (n_in %d out %d ws %zu)\n", n_in, out_size, ws_size); grid = -1; return; }
        int dev = 0, cus = 0, per_cu = 0;
        hipGetDevice(&dev); hipDeviceGetAttribute(&cus, hipDeviceAttributeMultiprocessorCount, dev);
        hipFuncSetAttribute((const void*)mega_fwd, hipFuncAttributeMaxDynamicSharedMemorySize, LDS_BYTES);
        hipOccupancyMaxActiveBlocksPerMultiprocessor(&per_cu, (const void*)mega_fwd, NTHREADS, LDS_BYTES);
        if (per_cu < 1) { fprintf(stderr, "kernel_launch: occupancy query says %d blocks/CU\n", per_cu); per_cu = 1; }
        grid = cus * 1;
        (void)hipGetLastError();
    }
    if (grid < 0) return;
    if (hipMemsetAsync((char*)d_ws, 0, 65536, stream) != hipSuccess) { fprintf(stderr, "kernel_launch: memset failed\n"); return; }
    Args a{};
    for (int i = 0; i < 27; ++i) a.in[i] = (const float*)d_in[i];
    a.out = (float*)d_out; a.ws = (unsigned char*)d_ws;
#if MK_MULTI
    for (int p = 0; p < NPHASE; ++p) for (int rep = 0; rep < ((((REPMASK) >> p) & 1) ? 2 : 1); ++rep) { a.ph_lo = p; a.ph_hi = p + 1; hipLaunchKernelGGL(mega_fwd, dim3(grid), dim3(NTHREADS), LDS_BYTES, stream, a); }
#else
    a.ph_lo = 0; a.ph_hi = NPHASE;
    void* kargs[] = {&a};
    hipError_t e = hipLaunchCooperativeKernel((const void*)mega_fwd, dim3(grid), dim3(NTHREADS), kargs, LDS_BYTES, stream);
    if (e != hipSuccess) fprintf(stderr, "cooperative launch failed: %s (grid %d)\n", hipGetErrorString(e), grid);
#endif
}
```

```cpp
#include <hip/hip_runtime.h>
#include <hip/hip_cooperative_groups.h>
#include <hip/hip_bf16.h>
#include <cstdio>
#include <cstdint>
#include <cmath>
namespace pg8 {
#define PG8_LAS __attribute__((address_space(3)))
typedef unsigned short bf16_t;
typedef short bf16x8 __attribute__((ext_vector_type(8)));
typedef float f32x4 __attribute__((ext_vector_type(4)));
typedef unsigned u32x4 __attribute__((ext_vector_type(4)));
constexpr int BM = 256, BK = 64, HALF = 128, HTB = HALF * BK * 2  , STAGE_BYTES = 8 * HTB, NXCD = 8, WGM = 8;

__host__ __device__ __forceinline__ int lds_byte(int r, int c) { const int st = (r >> 4) * 2 + (c >> 5), rr = r & 15, cc = c & 31, ob = rr * 64 + cc * 2; return st * 1024 + (ob ^ (((ob >> 9) & 1) << 5)); }
__host__ __device__ __forceinline__ void stage_rc(int b, int& R, int& C) { const int st = b / 1024, sb = b % 1024, swz = sb ^ (((sb >> 9) & 1) << 5); R = (st >> 1) * 16 + swz / 64; C = (st & 1) * 32 + (swz % 64) / 2; }
__host__ __device__ __forceinline__ int perm32(int rho) { const int n = rho >> 4, i = rho & 15; return 8 * (i >> 2) + 4 * n + (i & 3); }
struct Unit { int pm, pn; };
struct Gemm { const bf16_t* A; const bf16_t* Bt; int M, N, K; };

struct StaticOrder {
    int nM, nN, nwg, G, c;
    __host__ __device__ void init(int M, int N, int G_, int c_) { nM = M / BM; nN = N / BM; nwg = nM * nN; G = G_; c = c_; }
    __host__ __device__ bool next(int i, Unit& u) const {
        const long L = (long)i * G + c; if (L >= nwg) return false;
        int wgid = (int)L; { const int q = nwg / NXCD, r = nwg % NXCD, xcd = wgid % NXCD, off = wgid / NXCD; wgid = (xcd < r ? xcd * (q + 1) : r * (q + 1) + (xcd - r) * q) + off; }
        const int nig = WGM * nN, gid = wgid / nig, fm = gid * WGM, gsz = (nM - fm) < WGM ? (nM - fm) : WGM;
        u.pm = fm + ((wgid % nig) % gsz); u.pn = (wgid % nig) / gsz; return true;
    }
    __device__ __forceinline__ void a_ready(const Unit&) const {}
    __device__ __forceinline__ void done(const Unit&) const {}
};
__device__ __forceinline__ unsigned cvt_pk_bf16(float lo, float hi) { unsigned r; asm volatile("v_cvt_pk_bf16_f32 %0, %1, %2" : "=v"(r) : "v"(lo), "v"(hi)); return r; }
typedef float f32x2 __attribute__((ext_vector_type(2)));
struct GemmStd { const bf16_t* A; const bf16_t* Bt; int K, lda, ldb;
    __device__ __forceinline__ const char* aptr(const Unit& u) const { return (const char*)A + (size_t)u.pm * BM * lda * 2; }
    __device__ __forceinline__ const char* bptr(const Unit& u) const { return (const char*)Bt + (size_t)u.pn * BM * ldb * 2; } };
struct GemmF1 { const bf16_t* A; const bf16_t* Bt; int K, lda, ldb;
    __device__ __forceinline__ const char* aptr(const Unit&) const { return (const char*)A; }
    __device__ __forceinline__ const char* bptr(const Unit& u) const { return (const char*)Bt + ((size_t)((u.pm >> 3) * 2048 + u.pn * 256) * 1024 + (size_t)(u.pm & 7) * 128) * 2; } };
struct GemmF2 { const bf16_t* A; const bf16_t* Bt; int K, lda, ldb;
    __device__ __forceinline__ const char* aptr(const Unit& u) const { return (const char*)A + (size_t)(u.pm & 7) * 256 * 2048 * 2; }
    __device__ __forceinline__ const char* bptr(const Unit& u) const { return (const char*)Bt + (((size_t)(u.pm >> 3) * 1024 + (size_t)u.pn * 256) * 4096 + (size_t)((u.pm >> 2) & 1) * 2048) * 2; } };

struct EpiBf16 {
    static constexpr bool PERM = true, AFTER_DRAIN = false, HEADS = false;
    bf16_t* O; int ldc;
    __device__ __forceinline__ void operator()(const f32x4 (&acc)[2][2][4][2], const Unit& u, int wr, int wc, int fr, int fq) const {
        const int row0 = u.pm * BM + wr * 64 + fr, col0 = u.pn * BM + wc * 32 + 8 * fq;
#pragma unroll
        for (int ai = 0; ai < 2; ++ai)
#pragma unroll
            for (int m = 0; m < 4; ++m) { bf16_t* rowp = O + (size_t)(row0 + ai * HALF + m * 16) * ldc + col0;
#pragma unroll
                for (int bj = 0; bj < 2; ++bj) { const f32x4 v0 = acc[ai][bj][m][0], v1 = acc[ai][bj][m][1];
                    u32x4 w; w.x = cvt_pk_bf16(v0[0], v0[1]); w.y = cvt_pk_bf16(v0[2], v0[3]); w.z = cvt_pk_bf16(v1[0], v1[1]); w.w = cvt_pk_bf16(v1[2], v1[3]);
                    *(u32x4*)(rowp + bj * HALF) = w; } }
    }
};
struct EpiF1 {
    static constexpr bool PERM = true, AFTER_DRAIN = false, HEADS = false;
    bf16_t* YT;
    __device__ __forceinline__ void operator()(const f32x4 (&acc)[2][2][4][2], const Unit& u, int wr, int wc, int fr, int fq) const {
        const int b = u.pm >> 3, g = u.pm & 7; const float sc = 1.0f / 512.0f;
        const int col0 = u.pn * BM + wc * 32 + 8 * fq;
#pragma unroll
        for (int ai = 0; ai < 2; ++ai)
#pragma unroll
            for (int m = 0; m < 4; ++m) { bf16_t* rowp = YT + ((size_t)(b * 1024 + g * 128 + wr * 64 + m * 16 + fr)) * 4096 + ai * 2048 + col0;
#pragma unroll
                for (int bj = 0; bj < 2; ++bj) { const f32x4 v0 = acc[ai][bj][m][0] * sc, v1 = acc[ai][bj][m][1] * sc;
                    u32x4 w; w.x = cvt_pk_bf16(v0[0], v0[1]); w.y = cvt_pk_bf16(v0[2], v0[3]); w.z = cvt_pk_bf16(v1[0], v1[1]); w.w = cvt_pk_bf16(v1[2], v1[3]);
                    *(u32x4*)(rowp + bj * HALF) = w; }
                asm volatile("" ::: "memory"); }
    }
};
__device__ __forceinline__ float silu_mul(float g, float u) { return g * u * __builtin_amdgcn_rcpf(1.0f + __builtin_amdgcn_exp2f(-1.4426950408889634f * g)); }
struct EpiSwiglu {
    static constexpr bool PERM = true, AFTER_DRAIN = false, HEADS = false;
    bf16_t* O; int ldc;
    __device__ __forceinline__ void operator()(const f32x4 (&acc)[2][2][4][2], const Unit& u, int wr, int wc, int fr, int fq) const {
        const int row0 = u.pm * BM + wr * 64 + fr, col0 = u.pn * HALF + wc * 32 + 8 * fq;
#pragma unroll
        for (int ai = 0; ai < 2; ++ai)
#pragma unroll
            for (int m = 0; m < 4; ++m) { bf16_t* rowp = O + (size_t)(row0 + ai * HALF + m * 16) * ldc + col0;
                const f32x4 g0 = acc[ai][0][m][0], g1 = acc[ai][0][m][1], u0 = acc[ai][1][m][0], u1 = acc[ai][1][m][1];
                u32x4 w; w.x = cvt_pk_bf16(silu_mul(g0[0], u0[0]), silu_mul(g0[1], u0[1])); w.y = cvt_pk_bf16(silu_mul(g0[2], u0[2]), silu_mul(g0[3], u0[3]));
                w.z = cvt_pk_bf16(silu_mul(g1[0], u1[0]), silu_mul(g1[1], u1[1])); w.w = cvt_pk_bf16(silu_mul(g1[2], u1[2]), silu_mul(g1[3], u1[3]));
                *(u32x4*)rowp = w; }
    }
};
struct EpiResGate {
    static constexpr bool PERM = false, AFTER_DRAIN = false, HEADS = false;
    const float* base; float* out; const float* gate; int gstride;
    __device__ __forceinline__ void operator()(const f32x4 (&acc)[2][2][4][2], const Unit& u, int wr, int wc, int fr, int fq) const {
        const int col0 = u.pn * BM + wc * 32 + 4 * fq; const float* gp = gate + (size_t)(u.pm >> 3) * gstride + col0;
        f32x4 gv[2][2];
#pragma unroll
        for (int bj = 0; bj < 2; ++bj)
#pragma unroll
            for (int n = 0; n < 2; ++n) gv[bj][n] = *(const f32x4*)(gp + bj * HALF + n * 16);
#pragma unroll
        for (int ai = 0; ai < 2; ++ai)
#pragma unroll
            for (int m = 0; m < 4; ++m) { const size_t off = (size_t)(u.pm * BM + ai * HALF + wr * 64 + m * 16 + fr) * 1024 + col0;
#pragma unroll
                for (int bj = 0; bj < 2; ++bj)
#pragma unroll
                    for (int n = 0; n < 2; ++n) { const f32x4 bs = *(const f32x4*)(base + off + bj * HALF + n * 16); *(f32x4*)(out + off + bj * HALF + n * 16) = bs + gv[bj][n] * acc[ai][bj][m][n]; }
                if (m & 1) asm volatile("" ::: "memory"); }
    }
};

struct EpiProj {
    static constexpr bool PERM = false, AFTER_DRAIN = false, HEADS = true;
    bf16_t* O; const float* ropeC; const float* ropeS; const float* qg; const float* kg;
    __device__ __forceinline__ void operator()(const f32x4 (&acc)[2][2][4][2], const Unit& u, int wr, int wc, int fr, int fq) const {
        const int t = u.pn, rb = u.pm % 9; const bool isctx = rb == 0;
        const int mode = (t < 4) ? 1 : (t < 6) ? 0 : (t < 8) ? 2 : (wc < 2 ? 2 : 0);
        const bool isq = (t < 2) || (t == 6) || (t == 7);
        const bool dorope = (mode != 0) && !isctx;
        const float qs = isq ? 0.125f * 1.4426950408889634f : 1.0f;
        f32x4 g[2][2];
#pragma unroll
        for (int bj = 0; bj < 2; ++bj)
#pragma unroll
            for (int n = 0; n < 2; ++n) g[bj][n] = (mode == 2) ? *(const f32x4*)((t == 8 ? kg : qg) + bj * 32 + n * 16 + 4 * fq) : (f32x4){1.f, 1.f, 1.f, 1.f};
        bf16_t* obase = O + (size_t)(u.pm * BM + wr * 64 + fr) * 2304 + t * 256 + wc * 64 + 4 * fq;
#pragma unroll
        for (int m = 0; m < 4; ++m) {
            f32x4 c1 = (f32x4){1.f, 1.f, 1.f, 1.f}, s1 = (f32x4){0.f, 0.f, 0.f, 0.f};
            if (dorope) { c1 = *(const f32x4*)(ropeC + (m * 16 + fr) * 16 + 4 * fq); s1 = *(const f32x4*)(ropeS + (m * 16 + fr) * 16 + 4 * fq); }
#pragma unroll
            for (int ai = 0; ai < 2; ++ai) {
                f32x4 c0 = (f32x4){1.f, 1.f, 1.f, 1.f}, s0 = (f32x4){0.f, 0.f, 0.f, 0.f};
                if (dorope) { const int prow = (rb - 1) * 4 + ai * 2 + wr; c0 = *(const f32x4*)(ropeC + prow * 16 + 4 * fq); s0 = *(const f32x4*)(ropeS + prow * 16 + 4 * fq); }
                f32x4 a0 = acc[ai][0][m][0], a1 = acc[ai][0][m][1], b0 = acc[ai][1][m][0], b1 = acc[ai][1][m][1];
                float sc = qs;
                if (mode == 2) {
                    float ss = (a0[0] * a0[0] + a0[1] * a0[1]) + (a0[2] * a0[2] + a0[3] * a0[3]) + (a1[0] * a1[0] + a1[1] * a1[1]) + (a1[2] * a1[2] + a1[3] * a1[3])
                             + (b0[0] * b0[0] + b0[1] * b0[1]) + (b0[2] * b0[2] + b0[3] * b0[3]) + (b1[0] * b1[0] + b1[1] * b1[1]) + (b1[2] * b1[2] + b1[3] * b1[3]);
                    ss += __shfl_xor(ss, 16); ss += __shfl_xor(ss, 32);
                    const float rstd = 1.0f / sqrtf(ss * (1.0f / 64.0f) + 1e-6f);
                    a0 = a0 * rstd * g[0][0]; a1 = a1 * rstd * g[0][1]; b0 = b0 * rstd * g[1][0]; b1 = b1 * rstd * g[1][1];
                }
                const f32x4 oa0 = (a0 * c0 - a1 * s0) * sc, oa1 = (a1 * c0 + a0 * s0) * sc, ob0 = (b0 * c1 - b1 * s1) * sc, ob1 = (b1 * c1 + b0 * s1) * sc;
                bf16_t* rp = obase + (size_t)(ai * HALF + m * 16) * 2304;
                typedef unsigned u32x2 __attribute__((ext_vector_type(2)));
                u32x2 w;
                w.x = cvt_pk_bf16(oa0[0], oa0[1]); w.y = cvt_pk_bf16(oa0[2], oa0[3]); *(u32x2*)(rp) = w;
                w.x = cvt_pk_bf16(oa1[0], oa1[1]); w.y = cvt_pk_bf16(oa1[2], oa1[3]); *(u32x2*)(rp + 16) = w;
                w.x = cvt_pk_bf16(ob0[0], ob0[1]); w.y = cvt_pk_bf16(ob0[2], ob0[3]); *(u32x2*)(rp + 32) = w;
                w.x = cvt_pk_bf16(ob1[0], ob1[1]); w.y = cvt_pk_bf16(ob1[2], ob1[3]); *(u32x2*)(rp + 48) = w;
            }
            asm volatile("" ::: "memory");
        }
    }
};
template <class Epi, class G, class Sched, bool ALIGN_EPI = false, bool SP2 = false>
__device__ __forceinline__ void gemm_phase(PG8_LAS unsigned char* lds, const G g, const Sched& S, const Epi& E) {
    const int tid = threadIdx.x, wid = __builtin_amdgcn_readfirstlane(tid >> 6), lane = tid & 63, wr = wid >> 2, wc = wid & 3, fr = lane & 15, fq = lane >> 4;
    const int K = g.K, nt = K / BK;
    unsigned voffA[2], voffB[2];
#pragma unroll
    for (int i = 0; i < 2; ++i) { int R, C; stage_rc(tid * 16 + i * 8192, R, C); const int Rb = Epi::HEADS ? ((R >> 5) * 64 + (R & 31)) : Epi::PERM ? ((R & ~31) + perm32(R & 31)) : R;
        voffA[i] = (unsigned)(R * g.lda + C) * 2u; voffB[i] = (unsigned)(Rb * g.ldb + C) * 2u; }
    const size_t kstep = (size_t)(BK * 2);
    const size_t hstepA = (size_t)HALF * g.lda * 2, hstepB = (size_t)(Epi::HEADS ? 32 : HALF) * g.ldb * 2;
    const unsigned ldsw = (unsigned)wid * 1024u;
    const int aoff = lds_byte(wr * 64 + fr, fq * 8), boff = lds_byte(wc * 32 + fr, fq * 8);
#define PG8_SA(b, h) (((b) * 2 + (h)) * HTB)
#define PG8_SB(b, h) ((4 + (b) * 2 + (h)) * HTB)
#define PG8_STAGE(bufoff, gbase, voff) do { _Pragma("unroll") for (int _i = 0; _i < 2; ++_i) \
        __builtin_amdgcn_global_load_lds((const unsigned*)((const char*)(gbase) + (voff)[_i]), (PG8_LAS unsigned*)(lds + (bufoff) + ldsw + _i * 8192), 16, 0, 0); } while (0)
#define PG8_LDA(dst, b, h) do { _Pragma("unroll") for (int m = 0; m < 4; ++m) _Pragma("unroll") for (int k = 0; k < 2; ++k) dst[m][k] = *(const PG8_LAS bf16x8*)(lds + PG8_SA(b, h) + aoff + m * 2048 + k * 1024); } while (0)
#define PG8_LDB(dst, b, h) do { _Pragma("unroll") for (int n = 0; n < 2; ++n) _Pragma("unroll") for (int k = 0; k < 2; ++k) dst[n][k] = *(const PG8_LAS bf16x8*)(lds + PG8_SB(b, h) + boff + n * 2048 + k * 1024); } while (0)
#define PG8_MMA(ai, bj, At, Bt) do { __builtin_amdgcn_s_setprio(1); _Pragma("unroll") for (int m = 0; m < 4; ++m) _Pragma("unroll") for (int n = 0; n < 2; ++n) _Pragma("unroll") for (int k = 0; k < 2; ++k) \
        acc[ai][bj][m][n] = __builtin_amdgcn_mfma_f32_16x16x32_bf16(Bt[n][k], At[m][k], acc[ai][bj][m][n], 0, 0, 0); __builtin_amdgcn_s_setprio(0); } while (0)
#define PG8_WAIT_V(n) asm volatile("s_waitcnt vmcnt(" #n ")" ::: "memory")
#define PG8_WAIT_L(n) asm volatile("s_waitcnt lgkmcnt(" #n ")" ::: "memory")
#define PG8_BAR __builtin_amdgcn_s_barrier()
#define PG8_SCHED __builtin_amdgcn_sched_barrier(0)
    Unit cur, nxt; int ui = 0;
    if (!S.next(0, cur)) return;
    f32x4 acc[2][2][4][2];
#pragma unroll
    for (int a = 0; a < 2; ++a)
#pragma unroll
        for (int b = 0; b < 2; ++b)
#pragma unroll
            for (int m = 0; m < 4; ++m)
#pragma unroll
                for (int n = 0; n < 2; ++n) acc[a][b][m][n] = (f32x4){0.f, 0.f, 0.f, 0.f};
    bf16x8 At[4][2], B0[2][2], B1[2][2];
    const char* cA = g.aptr(cur); const char* cB = g.bptr(cur);
    S.a_ready(cur);
    if constexpr (SP2) {
        PG8_STAGE(PG8_SB(0, 0), cB, voffB); PG8_STAGE(PG8_SB(0, 1), cB + hstepB, voffB); PG8_STAGE(PG8_SA(0, 0), cA, voffA); PG8_STAGE(PG8_SA(0, 1), cA + hstepA, voffA);
        if (wr == 1) PG8_BAR;
        PG8_WAIT_V(2); PG8_BAR;
        PG8_STAGE(PG8_SB(1, 0), cB + kstep, voffB); PG8_STAGE(PG8_SA(1, 0), cA + kstep, voffA); PG8_STAGE(PG8_SB(1, 1), cB + hstepB + kstep, voffB);
        PG8_WAIT_V(6); PG8_BAR;
    } else {
        PG8_STAGE(PG8_SB(0, 0), cB, voffB); PG8_STAGE(PG8_SA(0, 0), cA, voffA); PG8_STAGE(PG8_SB(0, 1), cB + hstepB, voffB); PG8_STAGE(PG8_SA(0, 1), cA + hstepA, voffA);
        if (wr == 1) PG8_BAR;
        PG8_WAIT_V(4); PG8_BAR;
        PG8_STAGE(PG8_SB(1, 0), cB + kstep, voffB); PG8_STAGE(PG8_SA(1, 0), cA + kstep, voffA); PG8_STAGE(PG8_SB(1, 1), cB + hstepB + kstep, voffB);
        PG8_WAIT_V(6); PG8_BAR;
    }
    for (;;) {
        const bool has_next = S.next(ui + 1, nxt);
        const char* nA = has_next ? g.aptr(nxt) : cA; const char* nB = has_next ? g.bptr(nxt) : cB;
        for (int t = 0; t < nt; t += 2) {
            const bool last = (t == nt - 2);
            const char* a1 = cA + (size_t)(t + 1) * kstep;
            const char* a2 = last ? nA : cA + (size_t)(t + 2) * kstep; const char* b2 = last ? nB : cB + (size_t)(t + 2) * kstep;
            const char* a3 = a2 + kstep; const char* b3 = b2 + kstep;
            if (last && has_next) S.a_ready(nxt);
            if constexpr (SP2) {
            PG8_LDB(B0, 0, 0); PG8_LDB(B1, 0, 1); PG8_SCHED; PG8_LDA(At, 0, 0); PG8_STAGE(PG8_SA(1, 1), a1 + hstepA, voffA);
            PG8_WAIT_V(8); PG8_WAIT_L(0); PG8_BAR; PG8_MMA(0, 0, At, B0); PG8_MMA(0, 1, At, B1); PG8_BAR; PG8_SCHED;
            PG8_LDA(At, 0, 1); PG8_STAGE(PG8_SB(0, 0), b2, voffB); PG8_STAGE(PG8_SB(0, 1), b2 + hstepB, voffB); PG8_STAGE(PG8_SA(0, 0), a2, voffA);
            PG8_WAIT_V(8); PG8_WAIT_L(0); PG8_BAR; PG8_MMA(1, 0, At, B0); PG8_MMA(1, 1, At, B1); PG8_BAR; PG8_SCHED;
            PG8_LDB(B0, 1, 0); PG8_LDB(B1, 1, 1); PG8_SCHED; PG8_LDA(At, 1, 0); PG8_STAGE(PG8_SA(0, 1), a2 + hstepA, voffA);
            PG8_WAIT_V(8); PG8_WAIT_L(0); PG8_BAR; PG8_MMA(0, 0, At, B0); PG8_MMA(0, 1, At, B1); PG8_BAR; PG8_SCHED;
            PG8_LDA(At, 1, 1); PG8_STAGE(PG8_SB(1, 0), b3, voffB); PG8_STAGE(PG8_SB(1, 1), b3 + hstepB, voffB); PG8_STAGE(PG8_SA(1, 0), a3, voffA);
            PG8_WAIT_V(8); PG8_WAIT_L(0); PG8_BAR; PG8_MMA(1, 0, At, B0); PG8_MMA(1, 1, At, B1); PG8_BAR; PG8_SCHED;
            } else {
            PG8_LDB(B0, 0, 0); PG8_SCHED; PG8_LDA(At, 0, 0); PG8_STAGE(PG8_SA(1, 1), a1 + hstepA, voffA);
            PG8_WAIT_L(8); PG8_BAR; PG8_WAIT_L(0); PG8_MMA(0, 0, At, B0); PG8_BAR; PG8_SCHED;
            PG8_LDB(B1, 0, 1); PG8_STAGE(PG8_SB(0, 0), b2, voffB);
            PG8_BAR; PG8_WAIT_L(0); PG8_MMA(0, 1, At, B1); PG8_BAR;
            PG8_LDA(At, 0, 1); PG8_STAGE(PG8_SA(0, 0), a2, voffA);
            PG8_BAR; PG8_WAIT_L(0); PG8_MMA(1, 0, At, B0); PG8_BAR; PG8_SCHED;
            PG8_STAGE(PG8_SB(0, 1), b2 + hstepB, voffB);
            PG8_WAIT_V(6); PG8_BAR; PG8_MMA(1, 1, At, B1); PG8_BAR;
            PG8_LDB(B0, 1, 0); PG8_SCHED; PG8_LDA(At, 1, 0); PG8_STAGE(PG8_SA(0, 1), a2 + hstepA, voffA);
            PG8_WAIT_L(8); PG8_BAR; PG8_WAIT_L(0); PG8_MMA(0, 0, At, B0); PG8_BAR; PG8_SCHED;
            PG8_LDB(B1, 1, 1); PG8_STAGE(PG8_SB(1, 0), b3, voffB);
            PG8_BAR; PG8_WAIT_L(0); PG8_MMA(0, 1, At, B1); PG8_BAR;
            PG8_LDA(At, 1, 1); PG8_STAGE(PG8_SA(1, 0), a3, voffA);
            PG8_BAR; PG8_WAIT_L(0); PG8_MMA(1, 0, At, B0); PG8_BAR; PG8_SCHED;
            PG8_STAGE(PG8_SB(1, 1), b3 + hstepB, voffB);
            PG8_WAIT_V(6); PG8_BAR; PG8_MMA(1, 1, At, B1); PG8_BAR;
            }
        }
        if constexpr (ALIGN_EPI) { if (wr == 0) PG8_BAR; }
        if constexpr (!Epi::AFTER_DRAIN) { E(acc, cur, wr, wc, fr, fq); S.done(cur); }
        if (!has_next) break;
#pragma unroll
        for (int a = 0; a < 2; ++a)
#pragma unroll
            for (int b = 0; b < 2; ++b)
#pragma unroll
                for (int m = 0; m < 4; ++m)
#pragma unroll
                    for (int n = 0; n < 2; ++n) acc[a][b][m][n] = (f32x4){0.f, 0.f, 0.f, 0.f};
        cur = nxt; cA = nA; cB = nB; ++ui;
        if constexpr (ALIGN_EPI) { if (wr == 1) PG8_BAR; }
    }
    PG8_WAIT_V(0);
    if constexpr (!ALIGN_EPI) { if (wr == 0) PG8_BAR; }
    PG8_BAR;
    if constexpr (Epi::AFTER_DRAIN) { E.fused(acc, cur, wr, wc, fr, fq, lds, wid, lane); S.done(cur); }
#undef PG8_SA
#undef PG8_SB
#undef PG8_STAGE
#undef PG8_LDA
#undef PG8_LDB
#undef PG8_MMA
#undef PG8_WAIT_V
#undef PG8_WAIT_L
#undef PG8_BAR
#undef PG8_SCHED
}
}
namespace attn_body {
using bf16=__hip_bfloat16;
using bf16x8=__attribute__((ext_vector_type(8)))short;
using s16x4=__attribute__((ext_vector_type(4)))short;
using f32x16=__attribute__((ext_vector_type(16)))float;
using u32x4=__attribute__((ext_vector_type(4)))unsigned;
constexpr int D=64,DM=2304,NKEYS=2304;
constexpr int NW=8,QBLK=32,QB=QBLK*NW,KVBLK=64;
__device__ __forceinline__ int crow(int r,int hi){return (r&3)+8*(r>>2)+4*hi;}
#define SBAR() __builtin_amdgcn_sched_barrier(0)
__device__ __forceinline__ void cmask(f32x16&p0,f32x16&p1,int jb,int qrel,int hi){
  const float NEG=-INFINITY; int kb=64*jb+4*hi;
  #pragma unroll
  for(int r=0;r<16;++r){int kv=kb+(r&3)+8*(r>>2); if(kv>qrel)p0[r]=NEG; if(kv+32>qrel)p1[r]=NEG;}
}

constexpr int NSLOT=3, SLOTB=8192;
constexpr int LDS_K=0, LDS_V=NSLOT*SLOTB, LDS_WS=2*NSLOT*SLOTB, LDS_OST=LDS_WS+NW*64*4, LDS_BYTES=LDS_OST+NW*4096;
constexpr float C2=0.125f*1.4426950408889634f;
__device__ __forceinline__ void glds16(const void*gsrc,unsigned lds_dst){unsigned keep;
  asm volatile("s_mov_b32 %0, m0\n\ts_mov_b32 m0, %2\n\ts_nop 0\n\tglobal_load_lds_dwordx4 %1, off\n\ts_mov_b32 m0, %0":"=&s"(keep):"v"(gsrc),"s"(lds_dst):"memory");}
__device__ __forceinline__ float max3f(float a,float b,float c){float r;asm("v_max3_f32 %0, %1, %2, %3":"=v"(r):"v"(a),"v"(b),"v"(c));return r;}
__device__ __forceinline__ float max2f(float a,float b){float r;asm("v_max_f32_e32 %0, %1, %2":"=v"(r):"v"(a),"v"(b));return r;}
__device__ __forceinline__ float fadd_s(float a,float b){float r;asm("v_add_f32_e32 %0, %1, %2":"=v"(r):"v"(a),"v"(b));return r;}
__device__ __forceinline__ float fsub_s(float a,float b){float r;asm("v_sub_f32_e32 %0, %1, %2":"=v"(r):"v"(a),"v"(b));return r;}
typedef float f32x2_t __attribute__((ext_vector_type(2))); typedef __bf16 bf16x2_t __attribute__((ext_vector_type(2)));
__device__ __forceinline__ unsigned cvtpk_s(float lo,float hi){f32x2_t v={lo,hi};bf16x2_t b=__builtin_convertvector(v,bf16x2_t);return __builtin_bit_cast(unsigned,b);}
#define WAIT_BAR(N) asm volatile("s_waitcnt vmcnt(" #N ") lgkmcnt(0)\n\ts_barrier":::"memory")

__device__ __forceinline__ void qkt(f32x16&p0,f32x16&p1,const char*Kslot,const bf16x8*qr,const f32x16&negm,int r32,int hi){
  const char*kb=Kslot+hi*1024+r32*16;
  #pragma unroll
  for(int d0=0;d0<4;++d0){
    const bf16x8 b0=*reinterpret_cast<const bf16x8*>(kb+d0*2048);
    const bf16x8 b1=*reinterpret_cast<const bf16x8*>(kb+d0*2048+512);
    if(d0==0){p0=__builtin_amdgcn_mfma_f32_32x32x16_bf16(b0,qr[0],negm,0,0,0);p1=__builtin_amdgcn_mfma_f32_32x32x16_bf16(b1,qr[0],negm,0,0,0);}
    else{p0=__builtin_amdgcn_mfma_f32_32x32x16_bf16(b0,qr[d0],p0,0,0,0);p1=__builtin_amdgcn_mfma_f32_32x32x16_bf16(b1,qr[d0],p1,0,0,0);}}
}
typedef __attribute__((address_space(3))) const char* lds_cptr;
typedef short v4i16_t __attribute__((ext_vector_type(4)));
__device__ __forceinline__ void kload8(bf16x8*kf,lds_cptr kp){
  kf[0]=*(const __attribute__((address_space(3))) bf16x8*)(kp);      kf[1]=*(const __attribute__((address_space(3))) bf16x8*)(kp+512);
  kf[2]=*(const __attribute__((address_space(3))) bf16x8*)(kp+2048); kf[3]=*(const __attribute__((address_space(3))) bf16x8*)(kp+2560);
  kf[4]=*(const __attribute__((address_space(3))) bf16x8*)(kp+4096); kf[5]=*(const __attribute__((address_space(3))) bf16x8*)(kp+4608);
  kf[6]=*(const __attribute__((address_space(3))) bf16x8*)(kp+6144); kf[7]=*(const __attribute__((address_space(3))) bf16x8*)(kp+6656);
}
__device__ __forceinline__ void kload2(bf16x8*kf,lds_cptr kp,int j){ kf[2*j]=*(const __attribute__((address_space(3))) bf16x8*)(kp+j*2048); kf[2*j+1]=*(const __attribute__((address_space(3))) bf16x8*)(kp+j*2048+512); }
__device__ __forceinline__ s16x4 vtr(lds_cptr p){ return __builtin_bit_cast(s16x4,__builtin_amdgcn_ds_read_tr16_b64_v4i16((__attribute__((address_space(3))) v4i16_t*)p)); }
__device__ __forceinline__ float rowmax(const f32x16&p0,const f32x16&p1){
  float a=max3f(p0[0],p0[1],p1[0]),b=max3f(p0[2],p0[3],p1[1]);a=max3f(a,p1[2],p1[3]);
  #pragma unroll
  for(int r=4;r<16;r+=4){a=max3f(a,p0[r],p0[r+1]);b=max3f(b,p0[r+2],p0[r+3]);a=max3f(a,p1[r],p1[r+1]);b=max3f(b,p1[r+2],p1[r+3]);}
  const float m=max2f(a,b);
  auto rr=__builtin_amdgcn_permlane32_swap(__float_as_uint(m),__float_as_uint(m),false,false);
  return max2f(__uint_as_float(rr[0]),__uint_as_float(rr[1]));
}
__device__ __forceinline__ void pv(f32x16*o,int vb,bf16x8 pa0,bf16x8 pa1,bf16x8 pa2,bf16x8 pa3){
  #pragma unroll
  for(int d0=0;d0<2;++d0){s16x4 lo[4],hi[4];
    #pragma unroll
    for(int ks=0;ks<4;++ks){
      asm volatile("ds_read_b64_tr_b16 %0,%1 offset:%c2":"=&v"(lo[ks]):"v"(vb),"i"(d0*4096+ks*1024):"memory");
      asm volatile("ds_read_b64_tr_b16 %0,%1 offset:%c2":"=&v"(hi[ks]):"v"(vb),"i"(d0*4096+ks*1024+512):"memory");}
    asm volatile("s_waitcnt lgkmcnt(0)":::"memory");SBAR();
    #define PK(k) (bf16x8){lo[k][0],lo[k][1],lo[k][2],lo[k][3],hi[k][0],hi[k][1],hi[k][2],hi[k][3]}
    o[d0]=__builtin_amdgcn_mfma_f32_32x32x16_bf16(pa0,PK(0),o[d0],0,0,0);
    o[d0]=__builtin_amdgcn_mfma_f32_32x32x16_bf16(pa1,PK(1),o[d0],0,0,0);
    o[d0]=__builtin_amdgcn_mfma_f32_32x32x16_bf16(pa2,PK(2),o[d0],0,0,0);
    o[d0]=__builtin_amdgcn_mfma_f32_32x32x16_bf16(pa3,PK(3),o[d0],0,0,0);
    #undef PK
  }
}

#ifndef ATTN_STORE16
#define ATTN_STORE16(p,v) (*(u32x4*)(p)=(v))
#endif
template<int THRL> __device__ __forceinline__ void attn_unit(const bf16*Qb,const bf16*__restrict__ Kh,const bf16*__restrict__ Vh,bf16*Ob,char*shm){
  constexpr int opitch=1024;
  const int tid=threadIdx.x,lane=tid&63,r32=lane&31,hi=lane>>5; const int wid=__builtin_amdgcn_readfirstlane(tid>>6);
  const bf16*Qw=Qb+(long)(wid*QBLK)*DM;
  const unsigned lds0=(unsigned)(uintptr_t)shm;
  float*wsf=(float*)(shm+LDS_WS)+wid*64;
  const bf16*ksrc=Kh+(long)lane*DM+wid*8;
  const bf16*vsrc=Vh+(long)(16*(wid&3)+(lane>>2))*DM+(wid>>2)*32+(lane&3)*8;
  const unsigned kdst=lds0+LDS_K+wid*1024, vdst=lds0+LDS_V+wid*1024;
  #define DMA_K(t,slot) glds16(ksrc+(long)(t)*KVBLK*DM,(unsigned)__builtin_amdgcn_readfirstlane(kdst+(slot)))
  #define DMA_V(t,slot) glds16(vsrc+(long)(t)*KVBLK*DM,(unsigned)__builtin_amdgcn_readfirstlane(vdst+(slot)))
  const int vb0=(int)(lds0+LDS_V)+((lane>>4)&1)*32+(lane&3)*8+(4*hi+((lane&15)>>2))*64;
  const char*Kbase=shm+LDS_K; bf16x8 kf[8];
  const lds_cptr shm3=(lds_cptr)shm; const lds_cptr kp0=shm3+LDS_K+hi*1024+r32*16; const lds_cptr vp0=shm3+LDS_V+((lane>>4)&1)*32+(lane&3)*8+(4*hi+((lane&15)>>2))*64;
  const int NT=NKEYS/KVBLK;
  DMA_K(0,0);DMA_V(0,0);DMA_K(1,SLOTB);
  bf16x8 qr[4];
  #pragma unroll
  for(int d0=0;d0<4;++d0)qr[d0]=*reinterpret_cast<const bf16x8*>(&Qw[(long)r32*DM+d0*16+hi*8]);
  float mhat=0.f,l_reg=0.f;f32x16 o[2];o[0]=f32x16{};o[1]=f32x16{};f32x16 negm=f32x16{};asm volatile("":"+v"(negm));
  #define CMASK(P0,P1,t) do{}while(0)
  bool resc=false;
  #define START(P0,P1) do{ const float rm=rowmax(P0,P1); resc=false; \
    { const float dl=rm; mhat=fadd_s(mhat,dl); \
      _Pragma("unroll") for(int r=0;r<16;++r){P0[r]=fsub_s(P0[r],dl);P1[r]=fsub_s(P1[r],dl);} \
      _Pragma("unroll") for(int r=0;r<16;++r)negm[r]=-mhat; asm volatile("":"+v"(negm)); } \
    _Pragma("unroll") for(int r=0;r<16;++r)P0[r]=__builtin_amdgcn_exp2f(P0[r]); }while(0)
  #define RESC() do{ if(resc){ asm volatile("s_waitcnt lgkmcnt(0)":::"memory"); \
      _Pragma("unroll") for(int d_=0;d_<2;++d_) _Pragma("unroll") for(int r=0;r<16;++r)o[d_][r]*=wsf[crow(r,hi)]; } }while(0)
  f32x16 pA0,pA1,pB0,pB1;
  int sl_prev=0,sl_cur=0,sl_next=SLOTB;
  #define ROT() do{sl_prev=sl_cur;sl_cur=sl_next;sl_next=(sl_next==(NSLOT-1)*SLOTB)?0:sl_next+SLOTB;}while(0)
  DMA_K(2,2*SLOTB);
  WAIT_BAR(3);
  qkt(pA0,pA1,Kbase,qr,negm,r32,hi);asm volatile("s_nop 15\n\ts_nop 7":"+v"(pA0),"+v"(pA1));CMASK(pA0,pA1,0);
  START(pA0,pA1);
  _Pragma("unroll") for(int r=0;r<16;++r)pA1[r]=__builtin_amdgcn_exp2f(pA1[r]);
  WAIT_BAR(0);
  DMA_K(3,0);DMA_V(1,SLOTB);
  ROT();
  kload8(kf,kp0+sl_cur);
  WAIT_BAR(2);
  s16x4 vlo[8],vhi[8]; u32x4 pw0,pw1,pw2,pw3;
  #define PKW(P,B) cvtpk_s(P[B],P[B+1])
  #define PAF(k) __builtin_bit_cast(bf16x8,pw##k)
  #define VFR(i) (bf16x8){vlo[i][0],vlo[i][1],vlo[i][2],vlo[i][3],vhi[i][0],vhi[i][1],vhi[i][2],vhi[i][3]}
  #define PIN(x) asm volatile("":"+v"(x))
  #define MX3(a,b,c) __builtin_fmaxf(__builtin_fmaxf((a),(b)),(c))
  #define GAPA(MF,A0,A1,A2,A3,W0,W1,PW) do{ MF; sacc+=A0; sacc+=A1; sacc+=A2; sacc+=A3; PIN(sacc); W0; W1; PIN(PW); SBAR(); }while(0)
  #define EX(v) __builtin_amdgcn_exp2f(v)
  #define GAPB(MF,X,B) do{ MF; X[B]=EX(X[B]); X[B+1]=EX(X[B+1]); X[B+2]=EX(X[B+2]); X[B+3]=EX(X[B+3]); PIN(X); SBAR(); }while(0)
  #define VRD(i) do{ vlo[i]=vtr(vp_+(((i)>>2)*4096+((i)&3)*1024)); vhi[i]=vtr(vp_+(((i)>>2)*4096+((i)&3)*1024+512)); }while(0)
  #define KRD(G,j) do{ if(G){ kload2(kf,kp0+sl_next,j); SBAR(); } }while(0)
  #define STEP(C0,C1,P0,P1,t,GK,GV,GL) do{ SBAR(); \
    const lds_cptr vp_=vp0+sl_prev; \
    VRD(0); SBAR(); float sacc=(P0[0]+P0[1]); \
    GAPA(C0=__builtin_amdgcn_mfma_f32_32x32x16_bf16(kf[0],qr[0],negm,0,0,0), P0[2],P0[3],P0[4],P0[5],     pw0[0]=PKW(P0,0), pw0[1]=PKW(P0,2), pw0); \
    VRD(4); SBAR(); GAPA(C1=__builtin_amdgcn_mfma_f32_32x32x16_bf16(kf[1],qr[0],negm,0,0,0), P0[6],P0[7],P0[8],P0[9],     pw0[2]=PKW(P0,4), pw0[3]=PKW(P0,6), pw0); \
    VRD(1); SBAR(); GAPA(C0=__builtin_amdgcn_mfma_f32_32x32x16_bf16(kf[2],qr[1],C0,0,0,0),   P0[10],P0[11],P0[12],P0[13], pw1[0]=PKW(P0,8), pw1[1]=PKW(P0,10), pw1); \
    VRD(5); SBAR(); GAPA(C1=__builtin_amdgcn_mfma_f32_32x32x16_bf16(kf[3],qr[1],C1,0,0,0),   P0[14],P0[15],P1[0],P1[1],   pw1[2]=PKW(P0,12),pw1[3]=PKW(P0,14), pw1); \
    VRD(2); SBAR(); GAPA(C0=__builtin_amdgcn_mfma_f32_32x32x16_bf16(kf[4],qr[2],C0,0,0,0),   P1[2],P1[3],P1[4],P1[5],     pw2[0]=PKW(P1,0), pw2[1]=PKW(P1,2), pw2); \
    VRD(6); SBAR(); GAPA(C1=__builtin_amdgcn_mfma_f32_32x32x16_bf16(kf[5],qr[2],C1,0,0,0),   P1[6],P1[7],P1[8],P1[9],     pw2[2]=PKW(P1,4), pw2[3]=PKW(P1,6), pw2); \
    VRD(3); SBAR(); GAPA(C0=__builtin_amdgcn_mfma_f32_32x32x16_bf16(kf[6],qr[3],C0,0,0,0),   P1[10],P1[11],P1[12],P1[13], pw3[0]=PKW(P1,8), pw3[1]=PKW(P1,10), pw3); \
    VRD(7); SBAR(); GAPA(C1=__builtin_amdgcn_mfma_f32_32x32x16_bf16(kf[7],qr[3],C1,0,0,0),   P1[14],P1[15],0.f,0.f,       pw3[2]=PKW(P1,12),pw3[3]=PKW(P1,14), pw3); \
    l_reg+=sacc; \
    if(GK){DMA_K((t)+3,sl_cur);} if(GV){DMA_V((t)+1,sl_next);} \
    CMASK(C0,C1,t); \
    { float a=MX3(C0[0],C0[1],C1[0]),b=MX3(C0[2],C0[3],C1[1]); a=MX3(a,C1[2],C1[3]); \
      _Pragma("unroll") for(int r=4;r<16;r+=4){a=MX3(a,C0[r],C0[r+1]);b=MX3(b,C0[r+2],C0[r+3]);a=MX3(a,C1[r],C1[r+1]);b=MX3(b,C1[r+2],C1[r+3]);} \
      float rm=__builtin_fmaxf(a,b); { auto rr=__builtin_amdgcn_permlane32_swap(__float_as_uint(rm),__float_as_uint(rm),false,false); rm=__builtin_fmaxf(__uint_as_float(rr[0]),__uint_as_float(rr[1])); } \
      resc=false; \
      if(__builtin_expect(__any(rm>(float)THRL),0)){ const float dl=__builtin_fmaxf(rm,0.f); mhat+=dl; \
        _Pragma("unroll") for(int r=0;r<16;++r){C0[r]-=dl;C1[r]-=dl;} \
        _Pragma("unroll") for(int r=0;r<16;++r)negm[r]=-mhat; asm volatile("":"+v"(negm)); \
        const float f=__builtin_amdgcn_exp2f(-dl); l_reg*=f; if(hi==0)wsf[r32]=f; resc=true; } } \
    SBAR(); \
    GAPB(o[0]=__builtin_amdgcn_mfma_f32_32x32x16_bf16(PAF(0),VFR(0),o[0],0,0,0), C0,0); \
    GAPB(o[1]=__builtin_amdgcn_mfma_f32_32x32x16_bf16(PAF(0),VFR(4),o[1],0,0,0), C0,4); \
    KRD(GL,0); GAPB(o[0]=__builtin_amdgcn_mfma_f32_32x32x16_bf16(PAF(1),VFR(1),o[0],0,0,0), C0,8); \
    KRD(GL,1); GAPB(o[1]=__builtin_amdgcn_mfma_f32_32x32x16_bf16(PAF(1),VFR(5),o[1],0,0,0), C0,12); \
    KRD(GL,2); GAPB(o[0]=__builtin_amdgcn_mfma_f32_32x32x16_bf16(PAF(2),VFR(2),o[0],0,0,0), C1,0); \
    KRD(GL,3); GAPB(o[1]=__builtin_amdgcn_mfma_f32_32x32x16_bf16(PAF(2),VFR(6),o[1],0,0,0), C1,4); \
    GAPB(o[0]=__builtin_amdgcn_mfma_f32_32x32x16_bf16(PAF(3),VFR(3),o[0],0,0,0), C1,8); \
    GAPB(o[1]=__builtin_amdgcn_mfma_f32_32x32x16_bf16(PAF(3),VFR(7),o[1],0,0,0), C1,12); \
    }while(0)
  int t=1;
  for(;t+5<NT;t+=2){
    STEP(pB0,pB1,pA0,pA1,t,true,true,true);     WAIT_BAR(2); RESC(); ROT();
    STEP(pA0,pA1,pB0,pB1,t+1,true,true,true);   WAIT_BAR(2); RESC(); ROT();
  }
  #define ENDW(tt) do{ if((tt)+3<NT){WAIT_BAR(2);} else if((tt)+2<NT){WAIT_BAR(1);} else {WAIT_BAR(0);} }while(0)
  for(;t+1<NT;t+=2){
    STEP(pB0,pB1,pA0,pA1,t,(t+3<NT),(t+1<NT),(t+1<NT));       ENDW(t);   RESC(); ROT();
    STEP(pA0,pA1,pB0,pB1,t+1,(t+4<NT),(t+2<NT),(t+2<NT));     ENDW(t+1); RESC(); ROT();
  }
  STEP(pB0,pB1,pA0,pA1,NT-1,false,false,false); RESC();
  { float sacc=pB0[0]+pB0[1]; _Pragma("unroll") for(int r=2;r<16;++r)sacc+=pB0[r]; _Pragma("unroll") for(int r=0;r<16;++r)sacc+=pB1[r]; l_reg+=sacc;
    pw0=(u32x4){PKW(pB0,0),PKW(pB0,2),PKW(pB0,4),PKW(pB0,6)};pw1=(u32x4){PKW(pB0,8),PKW(pB0,10),PKW(pB0,12),PKW(pB0,14)};pw2=(u32x4){PKW(pB1,0),PKW(pB1,2),PKW(pB1,4),PKW(pB1,6)};pw3=(u32x4){PKW(pB1,8),PKW(pB1,10),PKW(pB1,12),PKW(pB1,14)};
    SBAR(); pv(o,vb0+sl_cur,PAF(0),PAF(1),PAF(2),PAF(3)); }
  #undef PKW
  #undef PAF
  #undef VFR
  #undef PIN
  #undef MX3
  #undef GAPA
  #undef GAPB
  #undef EX
  #undef VRD
  #undef KRD
  #undef STEP
  #undef ENDW
  {auto rr=__builtin_amdgcn_permlane32_swap(__float_as_uint(l_reg),__float_as_uint(l_reg),false,false);l_reg=__uint_as_float(rr[0])+__uint_as_float(rr[1]);}
  if(hi==0)wsf[32+r32]=l_reg;asm volatile("s_waitcnt lgkmcnt(0)":::"memory");
  float rli[16];
  #pragma unroll
  for(int r=0;r<16;++r)rli[r]=__builtin_amdgcn_rcpf(wsf[32+crow(r,hi)]);
  bf16*Ow=Ob+(long)(wid*QBLK)*opitch;
  { bf16*stg=(bf16*)(shm+LDS_OST)+wid*2048;
    #pragma unroll
    for(int r=0;r<16;++r){const int orow=crow(r,hi);
      #pragma unroll
      for(int d0=0;d0<2;++d0)stg[orow*64+d0*32+r32]=__float2bfloat16(o[d0][r]*rli[r]);}
    asm volatile("s_waitcnt lgkmcnt(0)":::"memory");
    #pragma unroll
    for(int i=0;i<4;++i){const int row=i*8+(lane>>3),ch=lane&7; const u32x4 v=*(const u32x4*)(stg+row*64+ch*8); ATTN_STORE16(Ow+(long)row*opitch+ch*8,v);} }
  asm volatile("s_waitcnt lgkmcnt(0)\n\ts_barrier":::"memory");
  #undef DMA_K
  #undef DMA_V
  #undef CMASK
  #undef START
  #undef RESC
  #undef ROT
}
constexpr int ATTN_LDS_BYTES=LDS_BYTES;
#undef SBAR
#undef WAIT_BAR
}
namespace cg = cooperative_groups;
#define LAS __attribute__((address_space(3)))
typedef unsigned short u16;
typedef unsigned v4u __attribute__((ext_vector_type(4)));
typedef unsigned v2u __attribute__((ext_vector_type(2)));
typedef float f32x4 __attribute__((ext_vector_type(4)));
#define LDS_WAIT() asm volatile("s_waitcnt lgkmcnt(0)" ::: "memory")
#define VM_WAIT() asm volatile("s_waitcnt vmcnt(0)" ::: "memory")
__device__ __forceinline__ unsigned f2bf(float f) { unsigned u = __builtin_bit_cast(unsigned, f); return (u + 0x7fffu + ((u >> 16) & 1u)) >> 16; }
__device__ __forceinline__ unsigned pk2(float lo, float hi) { return f2bf(lo) | (f2bf(hi) << 16); }
__device__ __forceinline__ float bflo(unsigned w) { return __uint_as_float(w << 16); }
__device__ __forceinline__ float bfhi(unsigned w) { return __uint_as_float(w & 0xffff0000u); }
__device__ __forceinline__ float wave_sum(float v) {
#pragma unroll
    for (int o = 1; o < 64; o <<= 1) v += __shfl_xor(v, o);
    return v;
}

#define XB_TMO      128
#define XB_XCNT(j)  (256  + 64 * (j))
#define XB_XSUB(j)  (1280 + 64 * (j))
#define XB_XGEN(j)  (2304 + 64 * (j))
#define XB_TOP      3328
#define XB_TOPGEN   3392
#define XCD_BAR_WORDS 3456
#define XB_SPIN_CAP (1u << 18)

__device__ __forceinline__ unsigned xb_ld(unsigned* p)              { return __hip_atomic_load(p, __ATOMIC_RELAXED, __HIP_MEMORY_SCOPE_AGENT); }
__device__ __forceinline__ unsigned xb_add(unsigned* p, unsigned v) { return __hip_atomic_fetch_add(p, v, __ATOMIC_RELAXED, __HIP_MEMORY_SCOPE_AGENT); }
__device__ __forceinline__ unsigned xb_xcc_id() { return (unsigned)__builtin_amdgcn_s_getreg((3 << 11) | 20) & 0xFu; }
#define XB_SPIN(cond, bar) do { unsigned _sp = 0; while (cond) { __builtin_amdgcn_s_sleep(1); \
    if ((++_sp & 255u) == 0u) { if (xb_ld(&(bar)[XB_TMO])) break; if (_sp > XB_SPIN_CAP) { atomicAdd(&(bar)[XB_TMO], 1u); break; } } } } while (0)

struct XcdBarrier {
    unsigned* bar; unsigned x;
    volatile LAS unsigned* st;
};

__device__ __forceinline__ XcdBarrier xcd_barrier_post(unsigned* bar, volatile LAS unsigned* st) {
    XcdBarrier b; b.bar = bar; b.x = xb_xcc_id(); b.st = st;
    if (threadIdx.x == 0) (void)xb_add(&bar[XB_XCNT(b.x)], 1u);
    return b;
}
__device__ __forceinline__ void xcd_barrier_complete(unsigned* bar, unsigned x, unsigned& nloc, unsigned& nx) {
    const unsigned G = gridDim.x * gridDim.y * gridDim.z;
    unsigned sum, cnt, mine, sp = 0u;
    for (;;) {
        sum = 0u; cnt = 0u; mine = 0u;
#pragma unroll
        for (unsigned j = 0; j < 16; ++j) { const unsigned c = xb_ld(&bar[XB_XCNT(j)]); sum += c; cnt += (c > 0u) ? 1u : 0u; mine = (j == x) ? c : mine; }
        if (sum == G) break;
        __builtin_amdgcn_s_sleep(1);
        if ((++sp & 255u) == 0u) { if (xb_ld(&bar[XB_TMO])) break; if (sp > XB_SPIN_CAP) { atomicAdd(&bar[XB_TMO], 1u); break; } }
    }
    nloc = mine > 0u ? mine : 1u; nx = cnt > 0u ? cnt : 1u;
}

__device__ __forceinline__ void xcd_barrier(const XcdBarrier& b) {
    asm volatile("s_waitcnt vmcnt(0)" ::: "memory");
    __syncthreads();
    if (threadIdx.x == 0) {
        unsigned* bar = b.bar;
        __builtin_amdgcn_s_waitcnt(0);
        unsigned nloc = b.st[0], nx = b.st[1];
        if (nloc == 0u) { xcd_barrier_complete(bar, b.x, nloc, nx); b.st[0] = nloc; b.st[1] = nx; }
        const unsigned old = xb_add(&bar[XB_XSUB(b.x)], 1u);
        const unsigned gen = old / nloc;
        if (old + 1u == (gen + 1u) * nloc) {
            __builtin_amdgcn_fence(__ATOMIC_RELEASE, "agent");
            asm volatile("s_waitcnt vmcnt(0)" ::: "memory");
            const unsigned og = xb_add(&bar[XB_TOP], 1u);
            const unsigned tg = og / nx;
            if (og + 1u == (tg + 1u) * nx) xb_add(&bar[XB_TOPGEN], 1u);
            else XB_SPIN(xb_ld(&bar[XB_TOPGEN]) == tg, bar);
            __builtin_amdgcn_fence(__ATOMIC_ACQUIRE, "agent");
            xb_add(&bar[XB_XGEN(b.x)], 1u);
            asm volatile("s_waitcnt vmcnt(0)" ::: "memory");
        } else {
            XB_SPIN(xb_ld(&bar[XB_XGEN(b.x)]) == gen, bar);
            __builtin_amdgcn_fence(__ATOMIC_ACQUIRE, "agent");
            asm volatile("s_waitcnt vmcnt(0)" ::: "memory");
        }
    }
    __syncthreads();
}


constexpr int NWAVES = 8, NTHREADS = 512;
constexpr int DM = 1024, NB = 8, SEQ = 2048, CTXL = 256, MTOK = NB * SEQ, RPB = CTXL + SEQ  , MST = NB * RPB, INW = 2304, DFF = 2816, NMOD = 6 * DM;
constexpr int OFF_AQ = 0, OFF_AK = 512, OFF_AV = 1024, OFF_BQ = 1536, OFF_BK = 2048, OFF_BV = 2176;
constexpr float EPS = 1e-6f;
constexpr size_t MiB = 1u << 20;
constexpr size_t WS_MODS = 1 * MiB, WS_ZERO_BYTES = 2 * MiB;
constexpr size_t WS_ROPEC = 2 * MiB, WS_ROPES = WS_ROPEC + 4096, WS_CS128 = 2 * MiB + 65536;
constexpr size_t WS_WIN = 3 * MiB, WS_WO0 = 8 * MiB, WS_GU0 = 10 * MiB, WS_DN0 = 21 * MiB, WS_WO1 = 27 * MiB, WS_GU1 = 29 * MiB, WS_DN1 = 40 * MiB, WS_WCS = 46 * MiB;
constexpr size_t WS_HC = 62 * MiB, WS_BIG = 98 * MiB, WS_ATT = 186 * MiB, WS_TMP = 218 * MiB, WS_END = 250 * MiB;
constexpr int LDS_BYTES = 147456, LUT_OFF = 131072, MISC_OFF = 131072 + 8192;
constexpr size_t WS_BAR = 4096;
constexpr int NPHASE = 17;

struct Args { const float* in[27]; float* out; unsigned char* ws; int ph_lo, ph_hi; };

__device__ __forceinline__ void p0_transpose_item(const float* W, int K, int N, u16* WT, int mode, int item, int lane) {
    const int nblk = N / 256, kb = item / nblk, nb = item - kb * nblk, k0 = 32 * kb, n0 = 256 * nb + 4 * lane;
    const float* src = W + (size_t)k0 * N + n0;
    f32x4 v[32];
#pragma unroll
    for (int k = 0; k < 32; ++k) v[k] = *(const f32x4*)(src + (size_t)k * N);
#pragma unroll
    for (int e = 0; e < 4; ++e) { const int n = n0 + e; int d = n;
        if (mode == 1) { const int up = n >= DFF, j = up ? n - DFF : n; d = (j >> 7) * 256 + up * 128 + (j & 127); }
        u16* dp = WT + (size_t)d * K + k0;
#pragma unroll
        for (int q = 0; q < 4; ++q) { v4u o; o.x = pk2(v[8 * q][e], v[8 * q + 1][e]); o.y = pk2(v[8 * q + 2][e], v[8 * q + 3][e]); o.z = pk2(v[8 * q + 4][e], v[8 * q + 5][e]); o.w = pk2(v[8 * q + 6][e], v[8 * q + 7][e]);
            *(v4u*)(dp + 8 * q) = o; } }
}

__device__ __forceinline__ const float* norm_src(const float* x, const float* ctx, bool stacked, int R, int& key) {
    if (stacked) { const int b = R / RPB, r = R - b * RPB;
        if (r < CTXL) { key = 8; return ctx + (size_t)(b * CTXL + r) * DM; } key = b; return x + (size_t)(b * SEQ + r - CTXL) * DM; }
    key = R >> 11; return x + (size_t)R * DM;
}
__device__ __forceinline__ void norm_rows(const float* x, const float* ctx, bool stacked, u16* dst, const float* g, const float* mods, int shift_off, int scale_off, int gw, int NGW, int lane) {
    const int nrows = stacked ? MST : MTOK, rpw = (nrows + NGW - 1) / NGW;
    const int R0 = gw * rpw, R1 = (R0 + rpw < nrows) ? R0 + rpw : nrows;
    if (R0 >= R1) return;
    f32x4 gs[4], sh[4]; int curkey = -1, key;
    const float* src = norm_src(x, ctx, stacked, R0, key);
    f32x4 v[4], nv[4];
#pragma unroll
    for (int j = 0; j < 4; ++j) v[j] = ((const f32x4*)src)[64 * j + lane];
    for (int R = R0; R < R1; ++R) {
        int nkey = key;
        if (R + 1 < R1) { const float* nsrc = norm_src(x, ctx, stacked, R + 1, nkey);
#pragma unroll
            for (int j = 0; j < 4; ++j) nv[j] = ((const f32x4*)nsrc)[64 * j + lane]; }
        if (key != curkey) { curkey = key; const float* mrow = mods + (size_t)key * NMOD;
#pragma unroll
            for (int j = 0; j < 4; ++j) { gs[j] = ((const f32x4*)g)[64 * j + lane] * (((const f32x4*)(mrow + scale_off))[64 * j + lane] + 1.0f); sh[j] = ((const f32x4*)(mrow + shift_off))[64 * j + lane]; } }
        float s = 0.f;
#pragma unroll
        for (int j = 0; j < 4; ++j) s += (v[j].x * v[j].x + v[j].y * v[j].y) + (v[j].z * v[j].z + v[j].w * v[j].w);
        const float rstd = 1.0f / sqrtf(wave_sum(s) * (1.0f / DM) + EPS);
        unsigned long long* o8 = (unsigned long long*)(dst + (size_t)R * DM) + lane;
#pragma unroll
        for (int j = 0; j < 4; ++j) { const f32x4 y = v[j] * rstd * gs[j] + sh[j];
            o8[64 * j] = (unsigned long long)pk2(y.x, y.y) | ((unsigned long long)pk2(y.z, y.w) << 32); }
#pragma unroll
        for (int j = 0; j < 4; ++j) v[j] = nv[j];
        key = nkey;
    }
}

__global__ void __launch_bounds__(NTHREADS, 2) mega_fwd(Args args) {
    extern __shared__ __attribute__((aligned(16))) unsigned char lds[];
    LAS unsigned char* L = (LAS unsigned char*)lds;
    const int tid = threadIdx.x, lane = tid & 63, wave = __builtin_amdgcn_readfirstlane(tid >> 6);
    const int G = gridDim.x, bx = blockIdx.x;
    const int vcu = (G % 8 == 0) ? (bx % 8) * (G / 8) + bx / 8 : bx;
    const int gw = vcu * NWAVES + wave, NGW = G * NWAVES;
    unsigned char* ws = args.ws;
    const float* x_in = args.in[0]; float* out = args.out;
    float* mods = (float*)(ws + WS_MODS);
    u16* HC = (u16*)(ws + WS_HC); u16* BIG = (u16*)(ws + WS_BIG); u16* ATT = (u16*)(ws + WS_ATT); u16* TMP = (u16*)(ws + WS_TMP);
    const int lo = args.ph_lo, hi = args.ph_hi;
    volatile LAS unsigned* MISC = (volatile LAS unsigned*)(L + MISC_OFF);
    if (tid < 2) MISC[tid] = 0u;
    __syncthreads();
    XcdBarrier bar = xcd_barrier_post((unsigned*)(ws + WS_BAR), MISC);
#ifndef PHMASK
#define PHMASK 0x1ffff
#endif
#define IN(k) (((PHMASK >> (k)) & 1) && lo <= (k) && (k) < hi)
#ifndef REPMASK
#define REPMASK 0
#endif
#ifndef TS_SEL
#define TS_SEL -1
#endif
#ifndef TS_DIV
#define TS_DIV 2000.0f
#endif
#define PH(k) if (IN(k) && ((TS_SEL < 0) || ((bx == 0 && tid == 0) ? (((unsigned long long*)(ws + 8192))[k] = __builtin_amdgcn_s_memrealtime(), true) : true)))
#define SEAM(k) do { if (IN((k) + 1)) { if ((k) == 0) cg::this_grid().sync(); else xcd_barrier(bar); } } while (0)

    PH(0) {
        LAS float* lut = (LAS float*)(L + LUT_OFF);
        for (int m = tid; m < 2048; m += NTHREADS) lut[m] = cospif((float)m * (1.0f / 1024.0f));
        __syncthreads();
        for (int it = bx; it < 48; it += G) {
            const int l = it / 24, nc = it % 24; const float* W = args.in[l ? 19 : 4]; const float* bias = args.in[l ? 20 : 5];
            LAS float* sv = (LAS float*)(L + wave * 16384);
            const int k0 = wave * 128;
#pragma unroll
            for (int bb = 0; bb < 9; ++bb)
#pragma unroll
                for (int h = 0; h < 2; ++h) { const int k = k0 + h * 64 + lane; const float v = bb < 8 ? args.in[1][bb * DM + k] : args.in[3][k]; sv[bb * 128 + h * 64 + lane] = v / (1.0f + __expf(-v)); }
            LDS_WAIT(); asm volatile("" ::: "memory");
            f32x4 acc[9];
#pragma unroll
            for (int bb = 0; bb < 9; ++bb) acc[bb] = (f32x4){0.f, 0.f, 0.f, 0.f};
            const float* wp = W + (size_t)k0 * NMOD + nc * 256 + 4 * lane;
#pragma unroll 16
            for (int kk = 0; kk < 128; ++kk) { const f32x4 w = *(const f32x4*)(wp + (size_t)kk * NMOD);
#pragma unroll
                for (int bb = 0; bb < 9; ++bb) acc[bb] += w * sv[bb * 128 + kk]; }
            LDS_WAIT(); asm volatile("" ::: "memory");
            LAS f32x4* red = (LAS f32x4*)(L + wave * 16384);
#pragma unroll
            for (int bb = 0; bb < 9; ++bb) red[bb * 64 + lane] = acc[bb];
            __syncthreads();
            for (int o = tid; o < 9 * 64; o += NTHREADS) { f32x4 s = (f32x4){0.f, 0.f, 0.f, 0.f};
#pragma unroll
                for (int w8 = 0; w8 < 8; ++w8) s += ((LAS f32x4*)(L + w8 * 16384))[o];
                const int bb = o >> 6, ln = o & 63; s += *(const f32x4*)(bias + nc * 256 + 4 * ln);
                *(f32x4*)(mods + (size_t)(l * 9 + bb) * NMOD + nc * 256 + 4 * ln) = s; }
            __syncthreads();
        }
        {
            constexpr int I_IN = 32 * 9, I_O = 32 * 4, I_GU = 32 * 22, I_DN = 88 * 4;
            constexpr int NIT = I_IN + 2 * (I_O + I_GU + I_DN);
            for (int it = gw; it < NIT; it += NGW) {
                int r = it;
                if (r < I_IN) { p0_transpose_item(args.in[7], DM, INW, (u16*)(ws + WS_WIN), 0, r, lane); continue; } r -= I_IN;
                if (r < I_O) { p0_transpose_item(args.in[15], DM, DM, (u16*)(ws + WS_WO0), 0, r, lane); continue; } r -= I_O;
                if (r < I_GU) { p0_transpose_item(args.in[17], DM, 2 * DFF, (u16*)(ws + WS_GU0), 1, r, lane); continue; } r -= I_GU;
                if (r < I_DN) { p0_transpose_item(args.in[18], DFF, DM, (u16*)(ws + WS_DN0), 0, r, lane); continue; } r -= I_DN;
                if (r < I_O) { p0_transpose_item(args.in[22], DM, DM, (u16*)(ws + WS_WO1), 0, r, lane); continue; } r -= I_O;
                if (r < I_GU) { p0_transpose_item(args.in[24], DM, 2 * DFF, (u16*)(ws + WS_GU1), 1, r, lane); continue; } r -= I_GU;
                p0_transpose_item(args.in[25], DFF, DM, (u16*)(ws + WS_DN1), 0, r, lane);
            }
        }
        for (int r = gw; r < 2048; r += NGW) {
            u16* row = (u16*)(ws + WS_WCS) + (size_t)r * 2048; const int k = r & 1023, ph = (r >= 1024) ? 512 : 0;
#pragma unroll 2
            for (int i = 0; i < 4; ++i) { const int n0 = (i * 64 + lane) * 8; float v[8];
#pragma unroll
                for (int e = 0; e < 8; ++e) v[e] = lut[(k * (n0 + e) - ph) & 2047];
                v4u o; o.x = pk2(v[0], v[1]); o.y = pk2(v[2], v[3]); o.z = pk2(v[4], v[5]); o.w = pk2(v[6], v[7]);
                *(v4u*)(row + n0) = o; }
        }
        for (int i = gw * 64 + lane; i < 256 * 128; i += NGW * 64) { const int r = i >> 7, j = i & 127, cs = r >> 7, jp = r & 127, m = ((jp * j) & 127) * 16;
            ((u16*)(ws + WS_CS128))[i] = (u16)f2bf(cs ? lut[(m - 512) & 2047] : lut[m]); }
        for (int i = gw * 64 + lane; i < 1024; i += NGW * 64) { const int pos = i >> 4, p = i & 15; const float inv = powf(10000.0f, -(float)p / 16.0f), ang = (float)pos * inv;
            ((float*)(ws + WS_ROPEC))[i] = cosf(ang); ((float*)(ws + WS_ROPES))[i] = sinf(ang); }
        SEAM(0);
    }
    PH(1) { norm_rows(x_in, args.in[2], true, HC, args.in[6], mods, 0 * DM, 1 * DM, gw, NGW, lane); SEAM(1); }
    PH(2) {
        pg8::GemmStd g{HC, (const u16*)(ws + WS_WIN), DM, DM, DM}; pg8::StaticOrder S; S.init(MST, INW, G, bx);
        pg8::EpiProj E{BIG, (const float*)(ws + WS_ROPEC), (const float*)(ws + WS_ROPES), args.in[13], args.in[14]};
        pg8::gemm_phase<pg8::EpiProj, pg8::GemmStd, pg8::StaticOrder, true, true>(L, g, S, E);
        SEAM(2);
    }
    PH(4) {
        typedef attn_body::bf16 abf;
        const abf* P = (const abf*)BIG;
        for (int s = vcu; s < 256; s += G) {
            const int b = s >> 5, i = s & 31;
            const abf* kvb = P + (size_t)b * RPB * INW;
            for (int r = 0; r < 6; ++r) {
                const abf *Qb, *Kh, *Vh; abf* Ob; int qb;
                if (r < 4) { const int h = i >> 3, m = r >> 1, v = r & 1; qb = i & 7;
                    Qb = kvb + (size_t)(CTXL + qb * 256) * INW + OFF_AQ + h * 128 + m * 64; Kh = kvb + OFF_AK + h * 128 + m * 64; Vh = kvb + OFF_AV + h * 128 + v * 64;
                    Ob = (abf*)TMP + (size_t)(b * SEQ + qb * 256) * DM + h * 256 + m * 128 + v * 64; }
                else { const int u = 2 * i + (r - 4), hq = u >> 3; qb = u & 7;
                    Qb = kvb + (size_t)(CTXL + qb * 256) * INW + OFF_BQ + hq * 64; Kh = kvb + OFF_BK + (hq >> 2) * 64; Vh = kvb + OFF_BV + (hq >> 2) * 64;
                    Ob = (abf*)ATT + (size_t)(b * SEQ + qb * 256) * DM + 512 + hq * 64; }
#ifndef SKIP_ATTN
                attn_body::attn_unit<8>(Qb, Kh, Vh, Ob, (char*)lds);
#endif
            }
        }
        asm volatile("" ::: "memory");
        for (int s = vcu; s < 256; s += G) {
            const int b = s >> 5, i = s & 31, qb = i & 7;
            {
                    VM_WAIT();
                    const float lam = expf(wave_sum(args.in[8][lane] * args.in[9][lane])) - expf(wave_sum(args.in[10][lane] * args.in[11][lane])) + 0.2f;
                    const int h = i >> 3, half = lane >> 5, l32 = lane & 31;
                    const f32x4 sg = *(const f32x4*)(args.in[12] + 4 * l32);
                    const size_t row0 = (size_t)(b * SEQ + qb * 256 + wave * 32);
                    for (int rr = 0; rr < 16; ++rr) { const size_t row = row0 + 2 * rr + half;
                        const unsigned long long* t1 = (const unsigned long long*)(TMP + row * DM + h * 256) + l32;
                        const unsigned long long a = __hip_atomic_load(t1, __ATOMIC_RELAXED, __HIP_MEMORY_SCOPE_AGENT), c = __hip_atomic_load(t1 + 32, __ATOMIC_RELAXED, __HIP_MEMORY_SCOPE_AGENT);
                        const unsigned a0 = (unsigned)a, a1 = (unsigned)(a >> 32), c0 = (unsigned)c, c1 = (unsigned)(c >> 32);
                        f32x4 d = (f32x4){bflo(a0) - lam * bflo(c0), bfhi(a0) - lam * bfhi(c0), bflo(a1) - lam * bflo(c1), bfhi(a1) - lam * bfhi(c1)};
                        float ss = (d.x * d.x + d.y * d.y) + (d.z * d.z + d.w * d.w);
                        ss += __shfl_xor(ss, 1); ss += __shfl_xor(ss, 2); ss += __shfl_xor(ss, 4); ss += __shfl_xor(ss, 8); ss += __shfl_xor(ss, 16);
                        const float rstd = 0.8f / sqrtf(ss * (1.0f / 128.0f) + EPS);
                        d = d * rstd * sg;
                        *(unsigned long long*)(ATT + row * DM + h * 128 + 4 * l32) = (unsigned long long)pk2(d.x, d.y) | ((unsigned long long)pk2(d.z, d.w) << 32); }
            }
        }
        SEAM(4);
    }
    PH(5) {
        pg8::GemmStd g{ATT, (const u16*)(ws + WS_WO0), DM, DM, DM}; pg8::StaticOrder S; S.init(MTOK, DM, G, bx);
        pg8::EpiResGate E{x_in, out, mods + 2 * DM, NMOD};
        pg8::gemm_phase<pg8::EpiResGate, pg8::GemmStd, pg8::StaticOrder, true, true>(L, g, S, E);
        SEAM(5);
    }
    const float* ml0 = mods; const float* ml1 = mods + (size_t)9 * NMOD;
        PH(6) { norm_rows(out, nullptr, false, HC, args.in[16], ml0, 3 * DM, 4 * DM, gw, NGW, lane); SEAM(6); }
        PH(7) {
            pg8::GemmStd g{HC, (const u16*)(ws + (WS_GU0)), DM, DM, DM}; pg8::StaticOrder S; S.init(MTOK, 2 * DFF, G, bx);
            pg8::EpiSwiglu E{BIG, DFF};
            pg8::gemm_phase<pg8::EpiSwiglu, pg8::GemmStd, pg8::StaticOrder, true, true>(L, g, S, E);
            SEAM(7);
        }
        PH(8) {
            pg8::GemmStd g{BIG, (const u16*)(ws + (WS_DN0)), DFF, DFF, DFF}; pg8::StaticOrder S; S.init(MTOK, DM, G, bx);
            pg8::EpiResGate E{out, out, ml0 + 5 * DM, NMOD};
            pg8::gemm_phase<pg8::EpiResGate, pg8::GemmStd, pg8::StaticOrder, true, true>(L, g, S, E);
            SEAM(8);
        }
            PH(9) { norm_rows(out, nullptr, false, HC, args.in[21], ml1, 0 * DM, 1 * DM, gw, NGW, lane); SEAM(9); }
            PH(10) {
                int k128 = 128; asm volatile("" : "+s"(k128));
                pg8::GemmF1 g{(const u16*)(ws + WS_CS128), HC, k128, 128, DM}; pg8::StaticOrder S; S.init(MTOK, 2048, G, bx);
                pg8::EpiF1 E{BIG};
                pg8::gemm_phase<pg8::EpiF1, pg8::GemmF1, pg8::StaticOrder, true, true>(L, g, S, E);
                SEAM(10);
            }
            PH(11) {
                pg8::GemmF2 g{(const u16*)(ws + WS_WCS), BIG, 2048, 2048, 4096}; pg8::StaticOrder S; S.init(MTOK, DM, G, bx);
                pg8::EpiBf16 E{TMP, DM};
                pg8::gemm_phase<pg8::EpiBf16, pg8::GemmF2, pg8::StaticOrder, true, true>(L, g, S, E);
                xcd_barrier(bar);
                for (int R = gw; R < NB * 1024; R += NGW) { const int b = R >> 10, k = R & 1023;
                    const v4u* pp = (const v4u*)(TMP + ((size_t)(b * 2048 + k)) * DM) + lane; const v4u* qp = (const v4u*)(TMP + ((size_t)(b * 2048 + 1024 + k)) * DM) + lane;
                    v4u* f1 = (v4u*)(ATT + ((size_t)(b * SEQ + k)) * DM) + lane; v4u* f2 = (v4u*)(ATT + ((size_t)(b * SEQ + (k ? SEQ - k : 0))) * DM) + lane;
#pragma unroll
                    for (int j = 0; j < 2; ++j) { const v4u p = pp[64 * j], q = qp[64 * j]; v4u a, c;
#pragma unroll
                        for (int e = 0; e < 4; ++e) { const float pl = bflo(p[e]), ph = bfhi(p[e]), ql = bflo(q[e]), qh = bfhi(q[e]); a[e] = pk2(pl - ql, ph - qh); c[e] = pk2(pl + ql, ph + qh); }
                        f1[64 * j] = a; if (k) f2[64 * j] = c; }
                }
                for (int R = gw; R < NB * 1024; R += NGW) {
                    const v4u* yp = (const v4u*)(BIG + (size_t)R * 4096) + lane; float sacc = 0.f;
#pragma unroll
                    for (int j = 0; j < 4; ++j) { const v4u y = yp[64 * j];
#pragma unroll
                        for (int e = 0; e < 4; ++e) sacc += bflo(y[e]) - bfhi(y[e]); }
                    sacc = wave_sum(sacc);
                    if (lane == 0) ATT[((size_t)((R >> 10) * SEQ + 1024)) * DM + (R & 1023)] = (u16)f2bf(sacc);
                }
                SEAM(11);
            }
            PH(12) {
                pg8::GemmStd g{ATT, (const u16*)(ws + WS_WO1), DM, DM, DM}; pg8::StaticOrder S; S.init(MTOK, DM, G, bx);
                pg8::EpiResGate E{out, out, ml1 + 2 * DM, NMOD};
                pg8::gemm_phase<pg8::EpiResGate, pg8::GemmStd, pg8::StaticOrder, true, true>(L, g, S, E);
                SEAM(12);
            }
        PH(13) { norm_rows(out, nullptr, false, HC, args.in[23], ml1, 3 * DM, 4 * DM, gw, NGW, lane); SEAM(13); }
        PH(14) {
            pg8::GemmStd g{HC, (const u16*)(ws + (WS_GU1)), DM, DM, DM}; pg8::StaticOrder S; S.init(MTOK, 2 * DFF, G, bx);
            pg8::EpiSwiglu E{BIG, DFF};
            pg8::gemm_phase<pg8::EpiSwiglu, pg8::GemmStd, pg8::StaticOrder, true, true>(L, g, S, E);
            SEAM(14);
        }
        PH(15) {
            pg8::GemmStd g{BIG, (const u16*)(ws + (WS_DN1)), DFF, DFF, DFF}; pg8::StaticOrder S; S.init(MTOK, DM, G, bx);
            pg8::EpiResGate E{out, out, ml1 + 5 * DM, NMOD};
            pg8::gemm_phase<pg8::EpiResGate, pg8::GemmStd, pg8::StaticOrder, true, true>(L, g, S, E);
            SEAM(15);
        }
    PH(16) {
        const float* g = args.in[26];
        for (int R = gw; R < MTOK; R += NGW) {
            f32x4* xr = (f32x4*)(out + (size_t)R * DM) + lane; f32x4 v[4]; float s = 0.f;
#pragma unroll
            for (int j = 0; j < 4; ++j) { v[j] = xr[64 * j]; s += (v[j].x * v[j].x + v[j].y * v[j].y) + (v[j].z * v[j].z + v[j].w * v[j].w); }
            const float rstd = 1.0f / sqrtf(wave_sum(s) * (1.0f / DM) + EPS);
#pragma unroll
            for (int j = 0; j < 4; ++j) xr[64 * j] = v[j] * rstd * ((const f32x4*)g)[64 * j + lane];
#if TS_SEL >= 0
            if (R == 0 && lane == 0) { const unsigned long long* ts = (const unsigned long long*)(ws + 8192); out[0] += (float)(ts[TS_SEL + 1] - ts[TS_SEL]) * (0.01f / TS_DIV); }
#endif
        }
    }
#undef IN
#undef SEAM
}

#ifndef MK_MULTI
#define MK_MULTI (REPMASK != 0)
#endif
extern "C" void kernel_launch(void* const* d_in, const int* in_sizes, int n_in, void* d_out, int out_size, void* d_ws, size_t ws_size, hipStream_t stream) {
    static int grid = 0;
    if (grid == 0) {
        if (n_in != 27 || out_size != MTOK * DM || ws_size < WS_END) { fprintf(stderr, "kernel_launch: unexpected shapes (n_in %d out %d ws %zu)\n", n_in, out_size, ws_size); grid = -1; return; }
        int dev = 0, cus = 0, per_cu = 0;
        hipGetDevice(&dev); hipDeviceGetAttribute(&cus, hipDeviceAttributeMultiprocessorCount, dev);
        hipFuncSetAttribute((const void*)mega_fwd, hipFuncAttributeMaxDynamicSharedMemorySize, LDS_BYTES);
        hipOccupancyMaxActiveBlocksPerMultiprocessor(&per_cu, (const void*)mega_fwd, NTHREADS, LDS_BYTES);
        if (per_cu < 1) { fprintf(stderr, "kernel_launch: occupancy query says %d blocks/CU\n", per_cu); per_cu = 1; }
        grid = cus * 1;
        (void)hipGetLastError();
    }
    if (grid < 0) return;
    if (hipMemsetAsync((char*)d_ws, 0, 65536, stream) != hipSuccess) { fprintf(stderr, "kernel_launch: memset failed\n"); return; }
    Args a{};
    for (int i = 0; i < 27; ++i) a.in[i] = (const float*)d_in[i];
    a.out = (float*)d_out; a.ws = (unsigned char*)d_ws;
#if MK_MULTI
    for (int p = 0; p < NPHASE; ++p) for (int rep = 0; rep < ((((REPMASK) >> p) & 1) ? 2 : 1); ++rep) { a.ph_lo = p; a.ph_hi = p + 1; hipLaunchKernelGGL(mega_fwd, dim3(grid), dim3(NTHREADS), LDS_BYTES, stream, a); }
#else
    a.ph_lo = 0; a.ph_hi = NPHASE;
    void* kargs[] = {&a};
    hipError_t e = hipLaunchCooperativeKernel((const void*)mega_fwd, dim3(grid), dim3(NTHREADS), kargs, LDS_BYTES, stream);
    if (e != hipSuccess) fprintf(stderr, "cooperative launch failed: %s (grid %d)\n", hipGetErrorString(e), grid);
#endif
}
```
